# Optimizing an MI355X kernel written in HIP

```python
import jax, jax.numpy as jnp
from jax import lax
import numpy as np

D_MODEL = 2048
BATCH = 8
SEQ = 2048
DEPTH = 2

N_MIXERS = 2
EXPAND = 2
BRANCH = EXPAND * D_MODEL
HEAD = 64
R_HEADS = BRANCH // HEAD
LORA_DECAY = 96
LORA_ICLR = 96
SHIFT_COLS = 3 * BRANCH + 2 * LORA_DECAY + 2 * LORA_ICLR
R_IN_COLS = SHIFT_COLS + BRANCH
CHUNK = 128
G_GROUPS = 16
G_GROUP_W = BRANCH // G_GROUPS
N_RWKV = (DEPTH + 1) // 2
N_GMLP = DEPTH // 2
RMS_EPS = 1e-5
LN_EPS = 1e-5
GN_EPS = 64e-5

kernel_name = "bidir_rwkv7_sgu_interleaved"


def rms_norm(x, g):
    xf = x.astype(jnp.float32)
    y = xf * lax.rsqrt(jnp.mean(xf * xf, axis=-1, keepdims=True) + RMS_EPS)
    return (y * g.astype(jnp.float32)).astype(x.dtype)


def layer_norm(x, g, b):
    xf = x.astype(jnp.float32)
    mu = jnp.mean(xf, axis=-1, keepdims=True)
    var = jnp.mean(jnp.square(xf - mu), axis=-1, keepdims=True)
    y = (xf - mu) * lax.rsqrt(var + LN_EPS)
    return (y * g.astype(jnp.float32) + b.astype(jnp.float32)).astype(x.dtype)


def shift_prev(z):
    return jnp.pad(z[:, :-1], ((0, 0), (1, 0), (0, 0)))


def shift_next(z):
    return jnp.pad(z[:, 1:], ((0, 0), (0, 1), (0, 0)))


def wkv_scan(r, w, k, v, a, b, reverse):
    Bsz, T, H, N = r.shape
    xs = tuple(jnp.moveaxis(t.astype(jnp.float32), 1, 0) for t in (r, w, k, v, a, b))

    def step(S, inp):
        r_t, w_t, k_t, v_t, a_t, b_t = inp
        sa = jnp.einsum('bhvk,bhk->bhv', S, a_t)
        S = (S * w_t[:, :, None, :]
             + sa[..., None] * b_t[:, :, None, :]
             + v_t[..., None] * k_t[:, :, None, :])
        y = jnp.einsum('bhvk,bhk->bhv', S, r_t)
        return S, y

    S0 = jnp.zeros((Bsz, H, N, N), jnp.float32)
    _, ys = lax.scan(step, S0, xs, reverse=reverse)
    return jnp.moveaxis(ys, 0, 1)


def rwkv7_bidir_mixer(h, w_in, mu_prev, mu_next, w0, w_up, a0, a_up, k_k, k_a, r_k,
                      ln_w, ln_b, w_out):
    Bsz, T, _ = h.shape
    z = h @ w_in
    zs, gate = z[..., :SHIFT_COLS], z[..., SHIFT_COLS:]
    zs = zs + mu_prev * (shift_prev(zs) - zs) + mu_next * (shift_next(zs) - zs)
    r, k, v, dw, da = jnp.split(
        zs, [BRANCH, 2 * BRANCH, 3 * BRANCH, 3 * BRANCH + 2 * LORA_DECAY], axis=-1)
    dw = dw.reshape(Bsz, T, 2, LORA_DECAY)
    da = da.reshape(Bsz, T, 2, LORA_ICLR)
    heads = lambda t: t.reshape(Bsz, T, R_HEADS, HEAD)

    kk = heads(k * k_k).astype(jnp.float32)
    kk = kk / jnp.maximum(jnp.linalg.norm(kk, axis=-1, keepdims=True), 1e-12)
    rh, vh = heads(r), heads(v)

    y = 0.0
    bonus = 0.0
    for d, rev in ((0, False), (1, True)):
        wll = -jax.nn.softplus(-(w0[d] + jnp.tanh(dw[:, :, d]) @ w_up[d])) - 0.5
        decay = jnp.exp(-jnp.exp(wll.astype(jnp.float32)))
        a_d = jax.nn.sigmoid(a0[d] + da[:, :, d] @ a_up[d])
        k_d = k * (1.0 + (a_d - 1.0) * k_a)
        a_h = heads(a_d).astype(jnp.float32)
        kd_h = heads(k_d)
        y = y + wkv_scan(rh, heads(decay), kd_h, vh, -kk, kk * a_h, rev)
        bonus = bonus + jnp.sum(rh * kd_h * r_k, axis=-1, keepdims=True) * vh

    mu = jnp.mean(y, axis=-1, keepdims=True)
    var = jnp.mean(jnp.square(y - mu), axis=-1, keepdims=True)
    yn = ((y - mu) * lax.rsqrt(var + GN_EPS)).reshape(Bsz, T, BRANCH)
    yn = (yn * ln_w.astype(jnp.float32) + ln_b.astype(jnp.float32)).astype(h.dtype)
    out = yn + bonus.reshape(Bsz, T, BRANCH)
    return (out * jax.nn.silu(gate)) @ w_out


def chunked_sgu_mixer(h, w_in, ln_g, ln_b, w_s, b_s, w_out):
    Bsz, T, _ = h.shape
    u, v, gate = jnp.split(h @ w_in, 3, axis=-1)
    u = jax.nn.gelu(u)
    v = layer_norm(jax.nn.gelu(v), ln_g, ln_b)
    vc = v.reshape(Bsz, T // CHUNK, CHUNK, G_GROUPS, G_GROUP_W)
    s = jnp.einsum('gij,bcjgd->bcigd', w_s, vc) + b_s.T[:, :, None]
    s = s.reshape(Bsz, T, BRANCH)
    return (u * s * jax.nn.silu(gate)) @ w_out


def setup_inputs(seed: int = 0) -> dict:
    key = jax.random.key(seed)
    ks = jax.random.split(key, 24)
    f = jnp.float32
    D, E = D_MODEL, BRANCH
    nrm = lambda k, shape, s: jax.random.normal(k, shape, f) * s
    return {
        "x": nrm(ks[0], (BATCH, SEQ, D), 1.0),
        "norm_g": 1.0 + nrm(ks[1], (DEPTH, D), 0.02),
        "final_norm_g": 1.0 + nrm(ks[2], (D,), 0.02),
        "rwkv_w_in": nrm(ks[3], (N_RWKV, D, R_IN_COLS), D ** -0.5),
        "rwkv_mu_prev": jax.random.uniform(ks[4], (N_RWKV, SHIFT_COLS), f, 0.0, 0.5),
        "rwkv_mu_next": jax.random.uniform(ks[5], (N_RWKV, SHIFT_COLS), f, 0.0, 0.5),
        "rwkv_w0": nrm(ks[6], (N_RWKV, 2, E), 0.5),
        "rwkv_w_up": nrm(ks[7], (N_RWKV, 2, LORA_DECAY, E), LORA_DECAY ** -0.5),
        "rwkv_a0": nrm(ks[8], (N_RWKV, 2, E), 0.1),
        "rwkv_a_up": nrm(ks[9], (N_RWKV, 2, LORA_ICLR, E), LORA_ICLR ** -0.5),
        "rwkv_k_k": 0.85 + nrm(ks[10], (N_RWKV, E), 0.02),
        "rwkv_k_a": 1.0 + nrm(ks[11], (N_RWKV, E), 0.02),
        "rwkv_r_k": nrm(ks[12], (N_RWKV, R_HEADS, HEAD), 0.1),
        "rwkv_ln_w": 1.0 + nrm(ks[13], (N_RWKV, E), 0.02),
        "rwkv_ln_b": nrm(ks[14], (N_RWKV, E), 0.02),
        "rwkv_w_out": nrm(ks[15], (N_RWKV, E, D), E ** -0.5),
        "gmlp_w_in": nrm(ks[16], (N_GMLP, D, 3 * E), D ** -0.5),
        "gmlp_ln_g": 1.0 + nrm(ks[17], (N_GMLP, E), 0.02),
        "gmlp_ln_b": nrm(ks[18], (N_GMLP, E), 0.02),
        "gmlp_w_s": nrm(ks[19], (N_GMLP, G_GROUPS, CHUNK, CHUNK), CHUNK ** -0.5),
        "gmlp_b_s": 1.0 + nrm(ks[20], (N_GMLP, G_GROUPS, CHUNK), 0.02),
        "gmlp_w_out": nrm(ks[21], (N_GMLP, E, D), E ** -0.5),
    }


def reference(x, norm_g, final_norm_g,
              rwkv_w_in, rwkv_mu_prev, rwkv_mu_next, rwkv_w0, rwkv_w_up, rwkv_a0, rwkv_a_up,
              rwkv_k_k, rwkv_k_a, rwkv_r_k, rwkv_ln_w, rwkv_ln_b, rwkv_w_out,
              gmlp_w_in, gmlp_ln_g, gmlp_ln_b, gmlp_w_s, gmlp_b_s, gmlp_w_out):
    h = x
    for i in range(DEPTH):
        z = rms_norm(h, norm_g[i])
        j = i // N_MIXERS
        if i % N_MIXERS == 0:
            y = rwkv7_bidir_mixer(z, rwkv_w_in[j], rwkv_mu_prev[j], rwkv_mu_next[j],
                                  rwkv_w0[j], rwkv_w_up[j], rwkv_a0[j], rwkv_a_up[j],
                                  rwkv_k_k[j], rwkv_k_a[j], rwkv_r_k[j],
                                  rwkv_ln_w[j], rwkv_ln_b[j], rwkv_w_out[j])
        else:
            y = chunked_sgu_mixer(z, gmlp_w_in[j], gmlp_ln_g[j], gmlp_ln_b[j],
                                  gmlp_w_s[j], gmlp_b_s[j], gmlp_w_out[j])
        h = h + y
    return rms_norm(h, final_norm_g)
```

```cpp
#include <hip/hip_runtime.h>
#include <hip/hip_cooperative_groups.h>
#include <cstdio>
#include <cstdint>
namespace cg = cooperative_groups;

#define GAS __attribute__((address_space(1)))
#define LAS __attribute__((address_space(3)))
typedef unsigned short bf16_t;
typedef short bf16x8 __attribute__((ext_vector_type(8)));
typedef float f32x4 __attribute__((ext_vector_type(4)));
typedef float f32x2 __attribute__((ext_vector_type(2)));
typedef unsigned u32x4 __attribute__((ext_vector_type(4)));
typedef unsigned u32x2 __attribute__((ext_vector_type(2)));

constexpr int NTHREADS = 512, NWAVES = 8;
constexpr int LDS_BYTES = 150528;
constexpr int MTOK = 16384, DM = 2048, BR = 4096, TSEQ = 2048, NB = 8, NH = 64;
constexpr int RIN = 16768, SHIFTC = 12672, NRKV = 12288, NLORA = 384, N1PAD = 12800;
constexpr size_t MiB = 1ull << 20;
constexpr size_t WS_Z = 0;
constexpr size_t WS_ZL = 384 * MiB;
constexpr size_t WS_A0 = 396 * MiB;
constexpr size_t WS_WRKV = 460 * MiB;
constexpr size_t WS_ZLP = 460 * MiB;
constexpr size_t WS_WG = 472 * MiB;
constexpr size_t WS_WO0 = 488 * MiB;
constexpr size_t WS_H1 = 0;
constexpr size_t WS_A1 = 128 * MiB;
constexpr size_t WS_WIN1 = 192 * MiB;
constexpr size_t WS_WO1 = 240 * MiB;
constexpr size_t WS_UG = 256 * MiB;
constexpr size_t WS_V = 384 * MiB;
constexpr size_t WS_MISC = 512 * MiB;
constexpr size_t WS_RSTD0 = WS_MISC;
constexpr size_t WS_STATS = WS_MISC + 65536;
constexpr size_t WS_WS = WS_MISC + 512 * 1024;
constexpr size_t WS_LORA = WS_MISC + 1 * MiB;
constexpr size_t WS_BSC = WS_MISC + 4 * MiB;
constexpr size_t WS_END = WS_MISC + 8 * MiB;

__device__ __forceinline__ unsigned f2bf(float f) { unsigned u = __builtin_bit_cast(unsigned, f); return (u + 0x7fffu + ((u >> 16) & 1u)) >> 16; }
typedef __bf16 bf16x2_t __attribute__((ext_vector_type(2)));
__device__ __forceinline__ unsigned pk2(float lo, float hi) { f32x2 v = {lo, hi}; bf16x2_t b = __builtin_convertvector(v, bf16x2_t); return __builtin_bit_cast(unsigned, b); }
__device__ __forceinline__ float bflo(unsigned w) { return __builtin_bit_cast(float, w << 16); }
__device__ __forceinline__ float bfhi(unsigned w) { return __builtin_bit_cast(float, w & 0xffff0000u); }
__device__ __forceinline__ void unpack8(u32x4 w, float* o) { o[0] = bflo(w.x); o[1] = bfhi(w.x); o[2] = bflo(w.y); o[3] = bfhi(w.y); o[4] = bflo(w.z); o[5] = bfhi(w.z); o[6] = bflo(w.w); o[7] = bfhi(w.w); }
__device__ __forceinline__ u32x4 pack8(const float* v) { u32x4 w; w.x = pk2(v[0], v[1]); w.y = pk2(v[2], v[3]); w.z = pk2(v[4], v[5]); w.w = pk2(v[6], v[7]); return w; }
__device__ __forceinline__ float fexp(float x) { return __builtin_amdgcn_exp2f(x * 1.4426950408889634f); }
__device__ __forceinline__ float frcp(float x) { return __builtin_amdgcn_rcpf(x); }
__device__ __forceinline__ float sigmoidf_(float x) { return frcp(1.f + fexp(-x)); }
__device__ __forceinline__ float siluf_(float x) { return x * sigmoidf_(x); }
__device__ __forceinline__ float geluf_(float x) { const float u = 1.5957691216057308f * (x + 0.044715f * x * x * x); return x * sigmoidf_(u); }
__device__ __forceinline__ float tanhf_(float x) { return 1.f - 2.f * frcp(1.f + fexp(2.f * x)); }
__device__ __forceinline__ float wave_sum(float v) {
#pragma unroll
    for (int o = 1; o < 64; o <<= 1) v += __shfl_xor(v, o);
    return v;
}
template <int CTRL> __device__ __forceinline__ float dppf(float v) { return __builtin_bit_cast(float, __builtin_amdgcn_update_dpp(0, __builtin_bit_cast(int, v), CTRL, 0xf, 0xf, true)); }
__device__ __forceinline__ float quad_sum(float v) { v += dppf<0xB1>(v); v += dppf<0x4E>(v); return v; }
__device__ __forceinline__ float oct_sum(float v) { v = quad_sum(v); v += dppf<0x141>(v); return v; }

namespace pg8 {
#define PG8_LAS __attribute__((address_space(3)))
constexpr int BM = 256, BK = 64, HALF = 128, HTB = HALF * BK * 2, STAGE_BYTES = 8 * HTB, NXCD = 8, WGM = 8;
__host__ __device__ __forceinline__ int lds_byte(int r, int c) { const int st = (r >> 4) * 2 + (c >> 5), rr = r & 15, cc = c & 31, ob = rr * 64 + cc * 2; return st * 1024 + (ob ^ (((ob >> 9) & 1) << 5)); }
__host__ __device__ __forceinline__ void stage_rc(int b, int& R, int& C) { const int st = b / 1024, sb = b % 1024, swz = sb ^ (((sb >> 9) & 1) << 5); R = (st >> 1) * 16 + swz / 64; C = (st & 1) * 32 + (swz % 64) / 2; }
__host__ __device__ __forceinline__ int perm32(int rho) { const int n = rho >> 4, i = rho & 15; return 8 * (i >> 2) + 4 * n + (i & 3); }
struct Unit { int pm, pn; };
struct Gemm { const bf16_t* A; const bf16_t* Bt; int M, N, K; };
struct StaticOrder {
    int nM, nN, nwg, G, c;
    __host__ __device__ void init(int M, int N, int G_, int c_) { nM = M / BM; nN = N / BM; nwg = nM * nN; G = G_; c = c_; }
    __host__ __device__ bool next(int i, Unit& u) const {
        const long L = (long)i * G + c; if (L >= nwg) return false;
        int wgid = (int)L; { const int q = nwg / NXCD, r = nwg % NXCD, xcd = wgid % NXCD, off = wgid / NXCD; wgid = (xcd < r ? xcd * (q + 1) : r * (q + 1) + (xcd - r) * q) + off; }
        const int nig = WGM * nN, gid = wgid / nig, fm = gid * WGM, gsz = (nM - fm) < WGM ? (nM - fm) : WGM;
        u.pm = fm + ((wgid % nig) % gsz); u.pn = (wgid % nig) / gsz; return true;
    }
    __device__ __forceinline__ void a_ready(const Unit&) const {}
    __device__ __forceinline__ void done(const Unit&) const {}
};
template <class Epi, class Sched, bool ALIGN_EPI = false, bool SP2 = false>
__device__ __forceinline__ void gemm_phase(PG8_LAS unsigned char* lds, const Gemm g, const Sched& S, const Epi& E, const int wv) {
    const int wid = wv, lane = (int)__builtin_amdgcn_mbcnt_hi(~0u, __builtin_amdgcn_mbcnt_lo(~0u, 0u)), tid = wid * 64 + lane, wr = wid >> 2, wc = wid & 3, fr = lane & 15, fq = lane >> 4;
    const int K = g.K, nt = K / BK;
    unsigned voffA[2], voffB[2];
#pragma unroll
    for (int i = 0; i < 2; ++i) { int R, C; stage_rc(tid * 16 + i * 8192, R, C); const int Rb = Epi::PERM ? ((R & ~31) + perm32(R & 31)) : R;
        voffA[i] = (unsigned)(R * K + C) * 2u; voffB[i] = (unsigned)(Rb * K + C) * 2u; }
    const size_t kstep = (size_t)(BK * 2);
    const size_t hstep = (size_t)HALF * K * 2;
    const size_t tstep = 2 * hstep;
    const unsigned ldsw = (unsigned)wid * 1024u;
    const int aoff = lds_byte(wr * 64 + fr, fq * 8), boff = lds_byte(wc * 32 + fr, fq * 8);
#define PG8_SA(b, h) (((b) * 2 + (h)) * HTB)
#define PG8_SB(b, h) ((4 + (b) * 2 + (h)) * HTB)
#define PG8_STAGE(bufoff, gbase, voff) do { _Pragma("unroll") for (int _i = 0; _i < 2; ++_i) \
        __builtin_amdgcn_global_load_lds((const unsigned*)((const char*)(gbase) + (voff)[_i]), (PG8_LAS unsigned*)(lds + (bufoff) + ldsw + _i * 8192), 16, 0, 0); } while (0)
#define PG8_LDA(dst, b, h) do { _Pragma("unroll") for (int m = 0; m < 4; ++m) _Pragma("unroll") for (int k = 0; k < 2; ++k) dst[m][k] = *(const PG8_LAS bf16x8*)(lds + PG8_SA(b, h) + aoff + m * 2048 + k * 1024); } while (0)
#define PG8_LDB(dst, b, h) do { _Pragma("unroll") for (int n = 0; n < 2; ++n) _Pragma("unroll") for (int k = 0; k < 2; ++k) dst[n][k] = *(const PG8_LAS bf16x8*)(lds + PG8_SB(b, h) + boff + n * 2048 + k * 1024); } while (0)
#define PG8_MMA(ai, bj, At, Bt) do { __builtin_amdgcn_s_setprio(1); _Pragma("unroll") for (int m = 0; m < 4; ++m) _Pragma("unroll") for (int n = 0; n < 2; ++n) _Pragma("unroll") for (int k = 0; k < 2; ++k) \
        acc[ai][bj][m][n] = __builtin_amdgcn_mfma_f32_16x16x32_bf16(Bt[n][k], At[m][k], acc[ai][bj][m][n], 0, 0, 0); __builtin_amdgcn_s_setprio(0); } while (0)
#define PG8_WAIT_V(n) asm volatile("s_waitcnt vmcnt(" #n ")" ::: "memory")
#define PG8_WAIT_L(n) asm volatile("s_waitcnt lgkmcnt(" #n ")" ::: "memory")
#define PG8_BAR __builtin_amdgcn_s_barrier()
#define PG8_SCHED __builtin_amdgcn_sched_barrier(0)
    Unit cur, nxt; int ui = 0;
    if (!S.next(0, cur)) return;
    f32x4 acc[2][2][4][2];
#pragma unroll
    for (int a = 0; a < 2; ++a)
#pragma unroll
        for (int b = 0; b < 2; ++b)
#pragma unroll
            for (int m = 0; m < 4; ++m)
#pragma unroll
                for (int n = 0; n < 2; ++n) acc[a][b][m][n] = (f32x4){0.f, 0.f, 0.f, 0.f};
    bf16x8 At[4][2], B0[2][2], B1[2][2];
    const char* cA = (const char*)g.A + (size_t)cur.pm * tstep; const char* cB = (const char*)g.Bt + (size_t)cur.pn * tstep;
    S.a_ready(cur);
    if constexpr (SP2) {
        PG8_STAGE(PG8_SB(0, 0), cB, voffB); PG8_STAGE(PG8_SB(0, 1), cB + hstep, voffB); PG8_STAGE(PG8_SA(0, 0), cA, voffA); PG8_STAGE(PG8_SA(0, 1), cA + hstep, voffA);
        if (wr == 1) PG8_BAR;
        PG8_WAIT_V(2); PG8_BAR;
        PG8_STAGE(PG8_SB(1, 0), cB + kstep, voffB); PG8_STAGE(PG8_SA(1, 0), cA + kstep, voffA); PG8_STAGE(PG8_SB(1, 1), cB + hstep + kstep, voffB);
        PG8_WAIT_V(6); PG8_BAR;
    } else {
        PG8_STAGE(PG8_SB(0, 0), cB, voffB); PG8_STAGE(PG8_SA(0, 0), cA, voffA); PG8_STAGE(PG8_SB(0, 1), cB + hstep, voffB); PG8_STAGE(PG8_SA(0, 1), cA + hstep, voffA);
        if (wr == 1) PG8_BAR;
        PG8_WAIT_V(4); PG8_BAR;
        PG8_STAGE(PG8_SB(1, 0), cB + kstep, voffB); PG8_STAGE(PG8_SA(1, 0), cA + kstep, voffA); PG8_STAGE(PG8_SB(1, 1), cB + hstep + kstep, voffB);
        PG8_WAIT_V(6); PG8_BAR;
    }
    for (;;) {
        const bool has_next = S.next(ui + 1, nxt);
        const char* nA = has_next ? (const char*)g.A + (size_t)nxt.pm * tstep : cA; const char* nB = has_next ? (const char*)g.Bt + (size_t)nxt.pn * tstep : cB;
        for (int t = 0; t < nt; t += 2) {
            const bool last = (t == nt - 2);
            const char* a1 = cA + (size_t)(t + 1) * kstep;
            const char* a2 = last ? nA : cA + (size_t)(t + 2) * kstep; const char* b2 = last ? nB : cB + (size_t)(t + 2) * kstep;
            const char* a3 = a2 + kstep; const char* b3 = b2 + kstep;
            if (last && has_next) S.a_ready(nxt);
            if constexpr (SP2) {
            PG8_LDB(B0, 0, 0); PG8_LDB(B1, 0, 1); PG8_SCHED; PG8_LDA(At, 0, 0); PG8_STAGE(PG8_SA(1, 1), a1 + hstep, voffA);
            PG8_WAIT_V(8); PG8_WAIT_L(0); PG8_BAR; PG8_MMA(0, 0, At, B0); PG8_MMA(0, 1, At, B1); PG8_BAR; PG8_SCHED;
            PG8_LDA(At, 0, 1); PG8_STAGE(PG8_SB(0, 0), b2, voffB); PG8_STAGE(PG8_SB(0, 1), b2 + hstep, voffB); PG8_STAGE(PG8_SA(0, 0), a2, voffA);
            PG8_WAIT_V(8); PG8_WAIT_L(0); PG8_BAR; PG8_MMA(1, 0, At, B0); PG8_MMA(1, 1, At, B1); PG8_BAR; PG8_SCHED;
            PG8_LDB(B0, 1, 0); PG8_LDB(B1, 1, 1); PG8_SCHED; PG8_LDA(At, 1, 0); PG8_STAGE(PG8_SA(0, 1), a2 + hstep, voffA);
            PG8_WAIT_V(8); PG8_WAIT_L(0); PG8_BAR; PG8_MMA(0, 0, At, B0); PG8_MMA(0, 1, At, B1); PG8_BAR; PG8_SCHED;
            PG8_LDA(At, 1, 1); PG8_STAGE(PG8_SB(1, 0), b3, voffB); PG8_STAGE(PG8_SB(1, 1), b3 + hstep, voffB); PG8_STAGE(PG8_SA(1, 0), a3, voffA);
            PG8_WAIT_V(8); PG8_WAIT_L(0); PG8_BAR; PG8_MMA(1, 0, At, B0); PG8_MMA(1, 1, At, B1); PG8_BAR; PG8_SCHED;
            } else {
            PG8_LDB(B0, 0, 0); PG8_SCHED; PG8_LDA(At, 0, 0); PG8_STAGE(PG8_SA(1, 1), a1 + hstep, voffA);
            PG8_WAIT_L(8); PG8_BAR; PG8_WAIT_L(0); PG8_MMA(0, 0, At, B0); PG8_BAR; PG8_SCHED;
            PG8_LDB(B1, 0, 1); PG8_STAGE(PG8_SB(0, 0), b2, voffB);
            PG8_BAR; PG8_WAIT_L(0); PG8_MMA(0, 1, At, B1); PG8_BAR;
            PG8_LDA(At, 0, 1); PG8_STAGE(PG8_SA(0, 0), a2, voffA);
            PG8_BAR; PG8_WAIT_L(0); PG8_MMA(1, 0, At, B0); PG8_BAR; PG8_SCHED;
            PG8_STAGE(PG8_SB(0, 1), b2 + hstep, voffB);
            PG8_WAIT_V(6); PG8_BAR; PG8_MMA(1, 1, At, B1); PG8_BAR;
            PG8_LDB(B0, 1, 0); PG8_SCHED; PG8_LDA(At, 1, 0); PG8_STAGE(PG8_SA(0, 1), a2 + hstep, voffA);
            PG8_WAIT_L(8); PG8_BAR; PG8_WAIT_L(0); PG8_MMA(0, 0, At, B0); PG8_BAR; PG8_SCHED;
            PG8_LDB(B1, 1, 1); PG8_STAGE(PG8_SB(1, 0), b3, voffB);
            PG8_BAR; PG8_WAIT_L(0); PG8_MMA(0, 1, At, B1); PG8_BAR;
            PG8_LDA(At, 1, 1); PG8_STAGE(PG8_SA(1, 0), a3, voffA);
            PG8_BAR; PG8_WAIT_L(0); PG8_MMA(1, 0, At, B0); PG8_BAR; PG8_SCHED;
            PG8_STAGE(PG8_SB(1, 1), b3 + hstep, voffB);
            PG8_WAIT_V(6); PG8_BAR; PG8_MMA(1, 1, At, B1); PG8_BAR;
            }
        }
        if constexpr (ALIGN_EPI) { if (wr == 0) PG8_BAR; }
        if constexpr (!Epi::AFTER_DRAIN) { E(acc, cur, wr, wc, fr, fq); S.done(cur); }
        if (!has_next) break;
#pragma unroll
        for (int a = 0; a < 2; ++a)
#pragma unroll
            for (int b = 0; b < 2; ++b)
#pragma unroll
                for (int m = 0; m < 4; ++m)
#pragma unroll
                    for (int n = 0; n < 2; ++n) acc[a][b][m][n] = (f32x4){0.f, 0.f, 0.f, 0.f};
        cur = nxt; cA = nA; cB = nB; ++ui;
        if constexpr (ALIGN_EPI) { if (wr == 1) PG8_BAR; }
    }
    PG8_WAIT_V(0);
    if constexpr (!ALIGN_EPI) { if (wr == 0) PG8_BAR; }
    PG8_BAR;
    if constexpr (Epi::AFTER_DRAIN) { E.fused(acc, cur, wr, wc, fr, fq, lds, wid, lane); S.done(cur); }
#undef PG8_SA
#undef PG8_SB
#undef PG8_STAGE
#undef PG8_LDA
#undef PG8_LDB
#undef PG8_MMA
#undef PG8_WAIT_V
#undef PG8_WAIT_L
#undef PG8_BAR
#undef PG8_SCHED
}
}
using pg8::Unit;
#define LDS_WAIT() asm volatile("s_waitcnt lgkmcnt(0)" ::: "memory")
typedef const f32x4 (&AccRef)[2][2][4][2];
__device__ __forceinline__ void fmac_s(float& acc, float a, float b) { asm("v_fmac_f32 %0, %1, %2" : "+v"(acc) : "v"(a), "v"(b)); }
__device__ __forceinline__ int fresh_tid(int wv) { int t = wv * 64 + (int)__builtin_amdgcn_mbcnt_hi(~0u, __builtin_amdgcn_mbcnt_lo(~0u, 0u)); asm volatile("" : "+v"(t)); return t; }

struct Params { const float* in[22]; float* out; unsigned char* ws; int ph_lo, ph_hi; };
enum { I_X = 0, I_NG, I_FNG, I_RWIN, I_MUP, I_MUN, I_W0, I_WUP, I_A0, I_AUP, I_KK, I_KA, I_RK, I_LNW, I_LNB, I_RWOUT, I_GWIN, I_GLNG, I_GLNB, I_GWS, I_GBS, I_GWOUT };

struct EpiZ {
    static constexpr bool PERM = true, AFTER_DRAIN = false;
    bf16_t* Z; bf16_t* ZL; const float* rstd;
    __device__ __forceinline__ void operator()(AccRef acc, const Unit& u, int wr, int wc, int fr, int fq) const {
        const int row0 = u.pm * 256 + wr * 64 + fr, colb = u.pn * 256 + wc * 32 + 8 * fq;
#pragma unroll
        for (int ai = 0; ai < 2; ++ai)
#pragma unroll
            for (int m = 0; m < 4; ++m) { const int row = row0 + ai * 128 + m * 16;
#pragma unroll
                for (int bj = 0; bj < 2; ++bj) { const int col = colb + bj * 128;
                    const f32x4 v0 = acc[ai][bj][m][0], v1 = acc[ai][bj][m][1];
                    u32x4 w; w.x = pk2(v0[0], v0[1]); w.y = pk2(v0[2], v0[3]); w.z = pk2(v1[0], v1[1]); w.w = pk2(v1[2], v1[3]);
                    if (col < NRKV) *(u32x4*)(Z + (size_t)row * NRKV + col) = w;
                    else if (col < SHIFTC) *(u32x4*)(ZL + (size_t)row * NLORA + (col - NRKV)) = w; } }
    }
};
struct EpiGate {
    static constexpr bool PERM = true, AFTER_DRAIN = false;
    bf16_t* O; const float* rstd;
    __device__ __forceinline__ void operator()(AccRef acc, const Unit& u, int wr, int wc, int fr, int fq) const {
        const int row0 = u.pm * 256 + wr * 64 + fr, colb = u.pn * 256 + wc * 32 + 8 * fq;
#pragma unroll
        for (int ai = 0; ai < 2; ++ai)
#pragma unroll
            for (int m = 0; m < 4; ++m) { const int row = row0 + ai * 128 + m * 16;
#pragma unroll
                for (int bj = 0; bj < 2; ++bj) { bf16_t* op = O + (size_t)row * BR + colb + bj * 128;
                    const u32x4 ow = *(const u32x4*)op; float o[8]; unpack8(ow, o);
                    const f32x4 g0 = acc[ai][bj][m][0], g1 = acc[ai][bj][m][1];
#pragma unroll
                    for (int e = 0; e < 4; ++e) { o[e] *= siluf_(g0[e]); o[4 + e] *= siluf_(g1[e]); }
                    *(u32x4*)op = pack8(o); } }
    }
};
struct EpiH1 {
    static constexpr bool PERM = true, AFTER_DRAIN = false;
    const float* X; bf16_t* A; float* sumsq;
    __device__ __forceinline__ void operator()(AccRef acc, const Unit& u, int wr, int wc, int fr, int fq) const {
        const int row0 = u.pm * 256 + wr * 64 + fr, colb = u.pn * 256 + wc * 32 + 8 * fq;
#pragma unroll
        for (int ai = 0; ai < 2; ++ai)
#pragma unroll
            for (int m = 0; m < 4; ++m) { const int row = row0 + ai * 128 + m * 16; float ss = 0.f;
#pragma unroll
                for (int bj = 0; bj < 2; ++bj) { const size_t off = (size_t)row * DM + colb + bj * 128;
                    const f32x4 h0 = *(const f32x4*)(X + off) + acc[ai][bj][m][0], h1 = *(const f32x4*)(X + off + 4) + acc[ai][bj][m][1];
                    u32x4 w; w.x = pk2(h0[0], h0[1]); w.y = pk2(h0[2], h0[3]); w.z = pk2(h1[0], h1[1]); w.w = pk2(h1[2], h1[3]); *(u32x4*)(A + off) = w;
                    ss += (h0[0] * h0[0] + h0[1] * h0[1]) + (h0[2] * h0[2] + h0[3] * h0[3]) + (h1[0] * h1[0] + h1[1] * h1[1]) + (h1[2] * h1[2] + h1[3] * h1[3]); }
                ss += __shfl_xor(ss, 16); ss += __shfl_xor(ss, 32);
                if (fq == 0) atomicAdd(sumsq + row, ss); }
    }
};
struct EpiH2 {
    static constexpr bool PERM = true, AFTER_DRAIN = false;
    const bf16_t* X; bf16_t* H; float* sumsq;
    __device__ __forceinline__ void operator()(AccRef acc, const Unit& u, int wr, int wc, int fr, int fq) const {
        const int row0 = u.pm * 256 + wr * 64 + fr, colb = u.pn * 256 + wc * 32 + 8 * fq;
#pragma unroll
        for (int ai = 0; ai < 2; ++ai)
#pragma unroll
            for (int m = 0; m < 4; ++m) { const int row = row0 + ai * 128 + m * 16; float ss = 0.f;
#pragma unroll
                for (int bj = 0; bj < 2; ++bj) { const size_t off = (size_t)row * DM + colb + bj * 128;
                    float x[8]; unpack8(*(const u32x4*)(X + off), x);
                    const f32x4 a0 = acc[ai][bj][m][0], a1 = acc[ai][bj][m][1];
                    float hv[8];
#pragma unroll
                    for (int e = 0; e < 4; ++e) { hv[e] = x[e] + a0[e]; hv[4 + e] = x[4 + e] + a1[e]; }
                    *(u32x4*)(H + off) = pack8(hv);
#pragma unroll
                    for (int e = 0; e < 8; ++e) ss += hv[e] * hv[e]; }
                ss += __shfl_xor(ss, 16); ss += __shfl_xor(ss, 32);
                if (fq == 0) atomicAdd(sumsq + row, ss); }
    }
};
struct EpiL1 {
    static constexpr bool PERM = true, AFTER_DRAIN = false;
    bf16_t* UG; bf16_t* V; const float* sumsq1; float* lnsum; float* lnsq;
    __device__ __forceinline__ void operator()(AccRef acc, const Unit& u, int wr, int wc, int fr, int fq) const {
        const int row0 = u.pm * 256 + wr * 64 + fr;
#pragma unroll
        for (int ai = 0; ai < 2; ++ai)
#pragma unroll
            for (int m = 0; m < 4; ++m) { const int row = row0 + ai * 128 + m * 16; const float rs = __builtin_amdgcn_rsqf(sumsq1[row] * (1.f / DM) + 1e-5f);
                if (u.pn < 32) { const int ch = u.pn * 128 + wc * 32 + 8 * fq; float o[8];
#pragma unroll
                    for (int n = 0; n < 2; ++n)
#pragma unroll
                        for (int e = 0; e < 4; ++e) o[4 * n + e] = geluf_(acc[ai][0][m][n][e] * rs) * siluf_(acc[ai][1][m][n][e] * rs);
                    *(u32x4*)(UG + (size_t)row * BR + ch) = pack8(o);
                } else { float s = 0.f, s2 = 0.f;
#pragma unroll
                    for (int bj = 0; bj < 2; ++bj) { const int ch = (u.pn - 32) * 256 + bj * 128 + wc * 32 + 8 * fq; float o[8];
#pragma unroll
                        for (int n = 0; n < 2; ++n)
#pragma unroll
                            for (int e = 0; e < 4; ++e) { const float g = geluf_(acc[ai][bj][m][n][e] * rs); o[4 * n + e] = g; s += g; s2 += g * g; }
                        *(u32x4*)(V + (size_t)row * BR + ch) = pack8(o); }
                    s += __shfl_xor(s, 16); s += __shfl_xor(s, 32); s2 += __shfl_xor(s2, 16); s2 += __shfl_xor(s2, 32);
                    if (fq == 0) { atomicAdd(lnsum + row, s); atomicAdd(lnsq + row, s2); } } }
    }
};

__device__ __forceinline__ void transpose_load(float (&v)[32], const float* W, int ldw, const float* g, int k0, int scol0, int lane) {
    if (scol0 >= 0) { const float* src = W + (size_t)(k0 + (lane >> 5)) * ldw + scol0 + (lane & 31);
#pragma unroll
        for (int i = 0; i < 32; ++i) v[i] = src[(size_t)(2 * i) * ldw];
        if (g) { const float* gp = g + k0 + (lane >> 5);
#pragma unroll
            for (int i = 0; i < 32; ++i) v[i] *= gp[2 * i]; }
    } else {
#pragma unroll
        for (int i = 0; i < 32; ++i) v[i] = 0.f; }
}
__device__ __forceinline__ void transpose_store(const float (&v)[32], int K, bf16_t* WT, LAS float* scr, int k0, int drow0, int lane) {
#pragma unroll
    for (int i = 0; i < 32; ++i) scr[(2 * i + (lane >> 5)) * 33 + (lane & 31)] = v[i];
    LDS_WAIT();
    const int c = lane & 7;
#pragma unroll
    for (int j = 0; j < 4; ++j) { const int n = (lane >> 3) + 8 * j; const LAS float* s = scr + (8 * c) * 33 + n;
        u32x4 o; o.x = pk2(s[0 * 33], s[1 * 33]); o.y = pk2(s[2 * 33], s[3 * 33]); o.z = pk2(s[4 * 33], s[5 * 33]); o.w = pk2(s[6 * 33], s[7 * 33]);
        *(u32x4*)(WT + (size_t)(drow0 + n) * K + k0 + 8 * c) = o; }
    LDS_WAIT();
}
template <class CM> __device__ __forceinline__ void convert_matrix(const float* W, int ldw, int K, int nrows, bf16_t* WT, const float* g, LAS float* scr, int gw, int NGW, int lane, CM colmap) {
    const int nblk = nrows / 32, nitems = (K / 64) * nblk;
    int it = gw;
    if (it >= nitems) return;
    float va[32], vb[32];
    transpose_load(va, W, ldw, g, 64 * (it / nblk), colmap(32 * (it % nblk)), lane);
    for (;;) {
        const int it1 = it + NGW;
        if (it1 < nitems) transpose_load(vb, W, ldw, g, 64 * (it1 / nblk), colmap(32 * (it1 % nblk)), lane);
        transpose_store(va, K, WT, scr, 64 * (it / nblk), 32 * (it % nblk), lane);
        if (it1 >= nitems) break;
        const int it2 = it1 + NGW;
        if (it2 < nitems) transpose_load(va, W, ldw, g, 64 * (it2 / nblk), colmap(32 * (it2 % nblk)), lane);
        transpose_store(vb, K, WT, scr, 64 * (it1 / nblk), 32 * (it1 % nblk), lane);
        if (it2 >= nitems) break;
        it = it2;
    }
}

constexpr int SCN = 37440;
constexpr int SI_X = 0, SI_H = 2304, SI_T = 4608, SI_V = 6656, SI_G7 = 8704, SI_SZ = 8960;
constexpr int SO_GT = 17920, SO_P = 18944, SO_UV = 20992, SO_Y = 23040, SO_L0 = 27136, SO_L1 = 29184, SO_C = 33280, SO_B = 37376;
static_assert(4 * SCN <= LDS_BYTES, "scan LDS");
constexpr int XS = 72;

#define WG_BAR() do { asm volatile("s_waitcnt lgkmcnt(0)" ::: "memory"); __builtin_amdgcn_s_barrier(); asm volatile("" ::: "memory"); } while (0)
__device__ __forceinline__ void scan_phase(LAS unsigned char* lds, const Params& p, const int pg, const int wv) {
    const int tid = fresh_tid(wv), lane = tid & 63, wave = __builtin_amdgcn_readfirstlane(tid >> 6);
    const int sc = wave & 3, role = wave >> 2, pair = sc >> 1, dir = sc & 1;
    const int bh = 2 * pg + pair, b = bh >> 6, h = bh & 63;
    LAS unsigned char* base = lds + sc * SCN;
    LAS float* GT = (LAS float*)(base + SO_GT);
    LAS float* Ps = (LAS float*)(base + SO_P);
    LAS bf16_t* UV = (LAS bf16_t*)(base + SO_UV);
    LAS float* yb = (LAS float*)(base + SO_Y);
    LAS float* lsc0 = (LAS float*)(base + SO_L0);
    LAS float* lsc1 = (LAS float*)(base + SO_L1);
    LAS float* cst = (LAS float*)(base + SO_C);
    LAS float* bon = (LAS float*)(base + SO_B);
    const int sn = lane & 7, kq = lane >> 4;
    const bf16_t* ZLb = (const bf16_t*)(p.ws + WS_ZLP) + (size_t)b * TSEQ * NLORA + dir * 96 + kq * 8;
    const bf16x8* lwu = (const bf16x8*)(p.ws + WS_LORA) + (size_t)(((((role == 0 ? 1 : 0) * 2 + dir) * 64 + h) * 12)) * 64;
    const unsigned ulane = (unsigned)lane;
#define WF_LOAD(w) do { unsigned _ul = ulane; asm volatile("" : "+v"(_ul));     \
        _Pragma("unroll") for (int ks = 0; ks < 3; ++ks) _Pragma("unroll") for (int nt = 0; nt < 4; ++nt) w[ks][nt] = lwu[(unsigned)((ks * 4 + nt) * 64) + _ul]; } while (0)
#define LORA_LOAD(sfv, cn, mat) do { const int _ts = dir ? (2047 - 8 * (cn) - sn) : (8 * (cn) + sn); \
        _Pragma("unroll") for (int ks = 0; ks < 3; ++ks) sfv[ks] = *(const bf16x8*)(ZLb + (size_t)_ts * NLORA + (mat) * 192 + ks * 32); } while (0)
#define LORA_MMA(wfv, sfv, dstp) do { _Pragma("unroll") for (int nt = 0; nt < 4; ++nt) { f32x4 _acc = (f32x4){0.f, 0.f, 0.f, 0.f}; \
        _Pragma("unroll") for (int ks = 0; ks < 3; ++ks) _acc = __builtin_amdgcn_mfma_f32_16x16x32_bf16(wfv[ks][nt], sfv[ks], _acc, 0, 0, 0); \
        if ((lane & 15) < 8) *(LAS f32x4*)((dstp) + (lane & 15) * 64 + 16 * nt + 4 * kq) = _acc; } } while (0)
    volatile LAS unsigned* pgall = (volatile LAS unsigned*)(lds + 149760 + 128);
    if (tid < 12) pgall[tid] = 0u;
    __syncthreads();
    volatile LAS unsigned* pgm = pgall + 2 * sc;
#define PAIR_PUBLISH(v) do { asm volatile("s_waitcnt lgkmcnt(0)" ::: "memory"); pgm[role] = (unsigned)(v); } while (0)
#define PAIR_WAIT(v) do { while (pgm[role ^ 1] < (unsigned)(v)) __builtin_amdgcn_s_sleep(3);        asm volatile("" ::: "memory"); } while (0)
    volatile LAS unsigned* pgx = pgall + 8;
    if (role == 0) {
        const int n = lane & 15, q = lane >> 4;
        f32x4 Sacc[4][4];
#pragma unroll
        for (int mt = 0; mt < 4; ++mt)
#pragma unroll
            for (int nt = 0; nt < 4; ++nt) Sacc[mt][nt] = (f32x4){0.f, 0.f, 0.f, 0.f};
        bf16x8 w1[3][4], sf1[3];
        WF_LOAD(w1); LORA_LOAD(sf1, 0, 1); LORA_MMA(w1, sf1, lsc1);
        WF_LOAD(w1); LORA_LOAD(sf1, 1, 1);
        PAIR_PUBLISH(1);
        for (int c = 0; c < 258; ++c) {
            PAIR_WAIT(c + 1);
            if (c + 1 < 256) LORA_MMA(w1, sf1, lsc1 + ((c + 1) & 1) * 512);
            __builtin_amdgcn_sched_barrier(0);
            if (c >= 1 && c <= 256) {
                const int cc = c - 1;
                const LAS unsigned char* in = base + (cc & 1) * SI_SZ;
                const LAS bf16_t* Xs = (const LAS bf16_t*)(in + SI_X); const LAS bf16_t* Hs = (const LAS bf16_t*)(in + SI_H); const LAS bf16_t* Tk = (const LAS bf16_t*)(in + SI_T);
                const LAS float* vb = (const LAS float*)(in + SI_V); const LAS float* g7 = (const LAS float*)(in + SI_G7);
                LAS float* yq = yb + (cc & 1) * 512;
                { f32x4 G = (f32x4){0.f, 0.f, 0.f, 0.f};
#pragma unroll
                  for (int ks = 0; ks < 2; ++ks) { const bf16x8 hf = *(const LAS bf16x8*)(Hs + n * XS + 32 * ks + 8 * q), xf = *(const LAS bf16x8*)(Xs + n * XS + 32 * ks + 8 * q);
                      G = __builtin_amdgcn_mfma_f32_16x16x32_bf16(hf, xf, G, 0, 0, 0); }
                  *(LAS f32x4*)(GT + n * 16 + 4 * q) = G; }
                __builtin_amdgcn_sched_barrier(0);
                { bf16x8 xp[2];
#pragma unroll
                  for (int ks = 0; ks < 2; ++ks) { const u32x2 lo = *(const LAS u32x2*)(Xs + n * XS + 32 * ks + 4 * q), hi = *(const LAS u32x2*)(Xs + n * XS + 32 * ks + 16 + 4 * q);
                      const u32x4 w = (u32x4){lo.x, lo.y, hi.x, hi.y}; xp[ks] = __builtin_bit_cast(bf16x8, w); }
#pragma unroll
                  for (int nt = 0; nt < 4; ++nt) { f32x4 acc = (f32x4){0.f, 0.f, 0.f, 0.f}; __builtin_amdgcn_sched_barrier(0);
#pragma unroll
                      for (int ks = 0; ks < 2; ++ks) { const f32x4 s0 = Sacc[2 * ks][nt], s1 = Sacc[2 * ks + 1][nt];
                          const u32x4 w = (u32x4){pk2(s0[0], s0[1]), pk2(s0[2], s0[3]), pk2(s1[0], s1[1]), pk2(s1[2], s1[3])};
                          acc = __builtin_amdgcn_mfma_f32_16x16x32_bf16(xp[ks], __builtin_bit_cast(bf16x8, w), acc, 0, 0, 0); }
                      LAS float* dst = (q < 2) ? (Ps + (16 * nt + n) * 8 + 4 * q) : (yq + (16 * nt + n) * 8 + 4 * (q - 2));
                      *(LAS f32x4*)dst = acc; } }
                LDS_WAIT();
                __builtin_amdgcn_sched_barrier(0);
                float sa[8], y[8], vj[8];
                { const f32x4 p0 = *(const LAS f32x4*)(Ps + lane * 8), p1 = *(const LAS f32x4*)(Ps + lane * 8 + 4), q0 = *(const LAS f32x4*)(yq + lane * 8), q1 = *(const LAS f32x4*)(yq + lane * 8 + 4);
#pragma unroll
                  for (int e = 0; e < 4; ++e) { sa[e] = p0[e]; sa[4 + e] = p1[e]; y[e] = q0[e]; y[4 + e] = q1[e]; }
#pragma unroll
                  for (int j = 0; j < 8; ++j) vj[j] = vb[j * 64 + lane]; }
#pragma unroll
                for (int s = 1; s < 8; ++s) { float g[16];
                    __builtin_amdgcn_sched_barrier(0);
#pragma unroll
                    for (int t = 0; t < 4; ++t) if ((t & 1) * 4 < s) { const f32x4 gv = *(const LAS f32x4*)(GT + s * 16 + 4 * t); g[4 * t] = gv[0]; g[4 * t + 1] = gv[1]; g[4 * t + 2] = gv[2]; g[4 * t + 3] = gv[3]; }
                    float acc = sa[s];
#pragma unroll
                    for (int j = 0; j < s; ++j) { fmac_s(acc, sa[j], g[j]); fmac_s(acc, vj[j], g[8 + j]); }
                    sa[s] = acc; }
#pragma unroll
                for (int s = 0; s < 8; ++s) { float g[16];
                    __builtin_amdgcn_sched_barrier(0);
#pragma unroll
                    for (int t = 0; t < 4; ++t) if ((t & 1) * 4 <= s) { const f32x4 gv = *(const LAS f32x4*)(GT + (8 + s) * 16 + 4 * t); g[4 * t] = gv[0]; g[4 * t + 1] = gv[1]; g[4 * t + 2] = gv[2]; g[4 * t + 3] = gv[3]; }
                    float acc = y[s];
#pragma unroll
                    for (int j = 0; j <= s; ++j) { fmac_s(acc, sa[j], g[j]); fmac_s(acc, vj[j], g[8 + j]); }
                    y[s] = acc; }
                *(LAS f32x4*)(yq + lane * 8) = (f32x4){y[0], y[1], y[2], y[3]}; *(LAS f32x4*)(yq + lane * 8 + 4) = (f32x4){y[4], y[5], y[6], y[7]};
                *(LAS u32x4*)(UV + lane * 16) = pack8(sa); *(LAS u32x4*)(UV + lane * 16 + 8) = pack8(vj);
                LDS_WAIT();
                __builtin_amdgcn_sched_barrier(0);
                { bf16x8 tk[4], uv[4]; f32x4 gv[4];
                  const u32x4 z4 = (u32x4){0u, 0u, 0u, 0u};
#pragma unroll
                  for (int t = 0; t < 4; ++t) { gv[t] = *(const LAS f32x4*)(g7 + 16 * t + 4 * q);
                      const u32x4 a = *(const LAS u32x4*)(Tk + (16 * t + n) * 16 + 8 * (q & 1)), bq = *(const LAS u32x4*)(UV + (16 * t + n) * 16 + 8 * (q & 1));
                      tk[t] = __builtin_bit_cast(bf16x8, a); uv[t] = __builtin_bit_cast(bf16x8, q < 2 ? bq : z4); }
#pragma unroll
                  for (int mt = 0; mt < 4; ++mt)
#pragma unroll
                      for (int nt = 0; nt < 4; ++nt) { __builtin_amdgcn_sched_barrier(0); Sacc[mt][nt] = __builtin_amdgcn_mfma_f32_16x16x32_bf16(tk[mt], uv[nt], Sacc[mt][nt] * gv[mt], 0, 0, 0); } }
                __builtin_amdgcn_sched_barrier(0);
            }
            PAIR_PUBLISH(c + 2);
            __builtin_amdgcn_sched_barrier(0);
            { const int cn2 = c + 2 < 256 ? c + 2 : 255; WF_LOAD(w1); LORA_LOAD(sf1, cn2, 1); }
        }
    } else {
        { const float* mup = p.in[I_MUP]; const float* mun = p.in[I_MUN]; const int hc = h * 64 + lane;
#pragma unroll
          for (int X = 0; X < 3; ++X) { const float a_ = mup[X * BR + hc], b_ = mun[X * BR + hc]; cst[X * 64 + lane] = 1.f - a_ - b_; cst[(3 + X) * 64 + lane] = a_; cst[(6 + X) * 64 + lane] = b_; }
          cst[9 * 64 + lane] = p.in[I_KK][hc]; cst[10 * 64 + lane] = p.in[I_KA][hc]; cst[11 * 64 + lane] = p.in[I_RK][hc];
          cst[12 * 64 + lane] = p.in[I_LNW][hc]; cst[13 * 64 + lane] = p.in[I_LNB][hc];
          cst[14 * 64 + lane] = p.in[I_W0][dir * BR + hc]; cst[15 * 64 + lane] = p.in[I_A0][dir * BR + hc]; }
        LDS_WAIT();
        const int i = lane >> 3, j = lane & 7;
        bf16x8 wf[3][4]; WF_LOAD(wf);
        const char* Zc = (const char*)((const bf16_t*)(p.ws + WS_Z) + (size_t)b * TSEQ * NRKV + h * 64);
        bf16_t* EX = (bf16_t*)p.out + (size_t)b * TSEQ * BR + h * 64 + 8 * j;
        float* BS = (float*)(p.ws + WS_BSC) + (size_t)b * TSEQ * 64 + h;
        const int src2 = 8 * ((i & ~3) + 1) + j, src3 = 24 + j;
        u32x4 x0[3], xm[3], xp[3]; u32x4 exn = (u32x4){0u, 0u, 0u, 0u}; float bon_n = 0.f;
#define ISSUE_Z(cn) do { const int _t = dir ? (2047 - 8 * (cn) - i) : (8 * (cn) + i); const unsigned _o = ((unsigned)_t * NRKV + 8u * (unsigned)j) * 2u; \
            const unsigned _om = _t > 0 ? _o - 2u * NRKV : _o, _op = _t < TSEQ - 1 ? _o + 2u * NRKV : _o; \
            _Pragma("unroll") for (int X = 0; X < 3; ++X) { const char* _zx = Zc + (size_t)X * (BR * 2); x0[X] = *(const u32x4*)(_zx + _o); xm[X] = *(const u32x4*)(_zx + _om); xp[X] = *(const u32x4*)(_zx + _op); } } while (0)
#define ISSUE_EX(ccn) do { const int _t = dir ? (2047 - 8 * (ccn) - i) : (8 * (ccn) + i); exn = *(const u32x4*)(EX + (size_t)_t * BR); bon_n = BS[(size_t)_t * 64]; } while (0)
#define LDC(dst, k) do { const f32x4 _a = *(const LAS f32x4*)(cst + (k) * 64 + 8 * j), _b = *(const LAS f32x4*)(cst + (k) * 64 + 8 * j + 4); dst[0] = (f32x2){_a[0], _a[1]}; dst[1] = (f32x2){_a[2], _a[3]}; dst[2] = (f32x2){_b[0], _b[1]}; dst[3] = (f32x2){_b[2], _b[3]}; } while (0)
#define LD8(dst, ptr) do { const f32x4 _a = *(const LAS f32x4*)(ptr), _b = *(const LAS f32x4*)((ptr) + 4); dst[0] = (f32x2){_a[0], _a[1]}; dst[1] = (f32x2){_a[2], _a[3]}; dst[2] = (f32x2){_b[0], _b[1]}; dst[3] = (f32x2){_b[2], _b[3]}; } while (0)
#define PK8(v) ((u32x4){pk2(v[0].x, v[0].y), pk2(v[1].x, v[1].y), pk2(v[2].x, v[2].y), pk2(v[3].x, v[3].y)})
        bf16x8 sf0[3];
        ISSUE_Z(0); LORA_LOAD(sf0, 0, 0);
        PAIR_PUBLISH(1);
        for (int c = 0; c < 258; ++c) {
            PAIR_WAIT(c + 1);
            if (c == 130) { while (pgx[sc ^ 1] < 131u) __builtin_amdgcn_s_sleep(1); asm volatile("" ::: "memory"); ISSUE_EX(128); }
            f32x2 rr[4], kp[4], vp[4];
            if (c < 256) {
                const int t = dir ? (2047 - 8 * c - i) : (8 * c + i);
                const bool hm = t > 0, hp = t < TSEQ - 1;
#pragma unroll
                for (int X = 0; X < 3; ++X) { f32x2 c0[4], cp[4], cn[4]; __builtin_amdgcn_sched_barrier(0); LDC(c0, X); LDC(cp, 3 + X); LDC(cn, 6 + X);
                    u32x4 wm = xm[X], wp = xp[X]; const u32x4 w0 = x0[X];
                    if (c == 0 || c == 255) { wm = hm ? wm : (u32x4){0u, 0u, 0u, 0u}; wp = hp ? wp : (u32x4){0u, 0u, 0u, 0u}; }
#pragma unroll
                    for (int qq = 0; qq < 4; ++qq) { const f32x2 z0 = (f32x2){bflo(w0[qq]), bfhi(w0[qq])}, zm = (f32x2){bflo(wm[qq]), bfhi(wm[qq])}, zp = (f32x2){bflo(wp[qq]), bfhi(wp[qq])};
                        const f32x2 z = zp * cn[qq] + (zm * cp[qq] + z0 * c0[qq]);
                        if (X == 0) rr[qq] = z; else if (X == 1) kp[qq] = z; else vp[qq] = z; } }
            }
            __builtin_amdgcn_sched_barrier(0);
            if (c >= 2) {
                const int cc = c - 2; const int t = dir ? (2047 - 8 * cc - i) : (8 * cc + i);
                const bool second = cc >= 128;
                const LAS float* yo = yb + (cc & 1) * 512 + (8 * j) * 8 + i;
                float y[8];
#pragma unroll
                for (int e = 0; e < 8; ++e) y[e] = yo[e * 8];
                const float bmine = bon[(cc & 1) * 8 + i];
                if (!second) { *(u32x4*)(EX + (size_t)t * BR) = pack8(y); if (j == 0) BS[(size_t)t * 64] = bmine; }
                else {
                    float e8[8]; unpack8(exn, e8); float s = 0.f;
#pragma unroll
                    for (int e = 0; e < 8; ++e) { y[e] += e8[e]; s += y[e]; }
                    const float mean = oct_sum(s) * (1.f / 64.f); float qq = 0.f;
#pragma unroll
                    for (int e = 0; e < 8; ++e) { y[e] -= mean; qq += y[e] * y[e]; }
                    const float rstd = __builtin_amdgcn_rsqf(oct_sum(qq) * (1.f / 64.f) + 64e-5f);
                    const LAS float* vin = (const LAS float*)(base + (cc & 1) * SI_SZ + SI_V) + i * 64 + 8 * j;
                    const f32x4 va = *(const LAS f32x4*)vin, vb2 = *(const LAS f32x4*)(vin + 4);
                    const f32x4 lwa = *(const LAS f32x4*)(cst + 12 * 64 + 8 * j), lwb = *(const LAS f32x4*)(cst + 12 * 64 + 8 * j + 4);
                    const f32x4 lba = *(const LAS f32x4*)(cst + 13 * 64 + 8 * j), lbb = *(const LAS f32x4*)(cst + 13 * 64 + 8 * j + 4);
                    const float bsum = bmine + bon_n; float o[8];
#pragma unroll
                    for (int e = 0; e < 4; ++e) { o[e] = y[e] * rstd * lwa[e] + lba[e] + bsum * va[e]; o[4 + e] = y[4 + e] * rstd * lwb[e] + lbb[e] + bsum * vb2[e]; }
                    *(u32x4*)(EX + (size_t)t * BR) = pack8(o);
                }
            }
            __builtin_amdgcn_sched_barrier(0);
            if (c < 256) {
                LORA_MMA(wf, sf0, lsc0);
                LDS_WAIT();
                LAS unsigned char* ob = base + (c & 1) * SI_SZ;
                LAS bf16_t* Xs = (LAS bf16_t*)(ob + SI_X); LAS bf16_t* Hs = (LAS bf16_t*)(ob + SI_H); LAS bf16_t* Tk = (LAS bf16_t*)(ob + SI_T);
                LAS float* vb = (LAS float*)(ob + SI_V); LAS float* g7 = (LAS float*)(ob + SI_G7);
                *(LAS f32x4*)(vb + i * 64 + 8 * j) = (f32x4){vp[0].x, vp[0].y, vp[1].x, vp[1].y}; *(LAS f32x4*)(vb + i * 64 + 8 * j + 4) = (f32x4){vp[2].x, vp[2].y, vp[3].x, vp[3].y};
                f32x2 cv[4], kk[4], ss2 = (f32x2){0.f, 0.f};
                LDC(cv, 9);
#pragma unroll
                for (int qq = 0; qq < 4; ++qq) { kk[qq] = kp[qq] * cv[qq]; ss2 = kk[qq] * kk[qq] + ss2; }
                const float inv = 1.f / fmaxf(sqrtf(oct_sum(ss2.x + ss2.y)), 1e-12f);
                __builtin_amdgcn_sched_barrier(0);
                f32x2 ad[4], kd[4];
                { f32x2 la2[4]; LD8(la2, lsc1 + (c & 1) * 512 + i * 64 + 8 * j); LDC(cv, 15);
#pragma unroll
                  for (int qq = 0; qq < 4; ++qq) { const f32x2 al = cv[qq] + la2[qq]; ad[qq] = (f32x2){sigmoidf_(al.x), sigmoidf_(al.y)}; kk[qq] = kk[qq] * inv; } }
                LDC(cv, 10);
#pragma unroll
                for (int qq = 0; qq < 4; ++qq) kd[qq] = kp[qq] * ((ad[qq] - 1.f) * cv[qq] + 1.f);
                LDC(cv, 11);
                { f32x2 bo2 = (f32x2){0.f, 0.f};
#pragma unroll
                  for (int qq = 0; qq < 4; ++qq) bo2 = (rr[qq] * kd[qq]) * cv[qq] + bo2;
                  const float bo = oct_sum(bo2.x + bo2.y);
                  if (j == 0) bon[(c & 1) * 8 + i] = bo; }
                __builtin_amdgcn_sched_barrier(0);
                f32x2 dec[4], inc[4];
                { f32x2 lw2[4]; LD8(lw2, lsc0 + i * 64 + 8 * j); LDC(cv, 14);
#pragma unroll
                  for (int qq = 0; qq < 4; ++qq) { const f32x2 wl = cv[qq] + lw2[qq];
                      dec[qq] = (f32x2){fexp(-0.6065306597126334f * sigmoidf_(wl.x)), fexp(-0.6065306597126334f * sigmoidf_(wl.y))}; } }
#pragma unroll
                for (int qq = 0; qq < 4; ++qq) { float xs[2] = {dec[qq].x, dec[qq].y};
#pragma unroll
                    for (int hh = 0; hh < 2; ++hh) { float x = xs[hh];
                        x *= __builtin_bit_cast(float, __builtin_amdgcn_update_dpp(0x3f800000, __builtin_bit_cast(int, x), 0x118, 0xf, 0xf, false));
                        const float t2 = __shfl(x, src2); x = (i & 2) ? x * t2 : x;
                        const float t3 = __shfl(x, src3); x = (i & 4) ? x * t3 : x;
                        xs[hh] = x; }
                    inc[qq] = (f32x2){xs[0], xs[1]}; }
                if (i == 7) { *(LAS f32x4*)(g7 + 8 * j) = (f32x4){inc[0].x, inc[0].y, inc[1].x, inc[1].y}; *(LAS f32x4*)(g7 + 8 * j + 4) = (f32x4){inc[2].x, inc[2].y, inc[3].x, inc[3].y}; }
                f32x2 bhv[4], khv[4];
                { f32x2 at[4], rt[4];
#pragma unroll
                  for (int qq = 0; qq < 4; ++qq) { const f32x2 ig = (f32x2){frcp(inc[qq].x), frcp(inc[qq].y)}, ex = inc[qq] * (f32x2){frcp(dec[qq].x), frcp(dec[qq].y)};
                      at[qq] = -(kk[qq] * ex); rt[qq] = rr[qq] * inc[qq]; bhv[qq] = (kk[qq] * ad[qq]) * ig; khv[qq] = kd[qq] * ig; }
                  *(LAS u32x4*)(Xs + i * XS + 8 * j) = PK8(at); *(LAS u32x4*)(Xs + (8 + i) * XS + 8 * j) = PK8(rt);
                  *(LAS u32x4*)(Hs + i * XS + 8 * j) = PK8(bhv); *(LAS u32x4*)(Hs + (8 + i) * XS + 8 * j) = PK8(khv); }
                LDS_WAIT();
                { f32x2 gg[4]; LD8(gg, g7 + 8 * j);
#pragma unroll
                  for (int qq = 0; qq < 4; ++qq) { const f32x2 bc = bhv[qq] * gg[qq], kc = khv[qq] * gg[qq];
                      const unsigned wb = pk2(bc.x, bc.y), wk = pk2(kc.x, kc.y);
                      Tk[(8 * j + 2 * qq) * 16 + i] = (bf16_t)wb; Tk[(8 * j + 2 * qq + 1) * 16 + i] = (bf16_t)(wb >> 16);
                      Tk[(8 * j + 2 * qq) * 16 + 8 + i] = (bf16_t)wk; Tk[(8 * j + 2 * qq + 1) * 16 + 8 + i] = (bf16_t)(wk >> 16); } }
            }
            PAIR_PUBLISH(c + 2);
            asm volatile("s_waitcnt vmcnt(0)" ::: "memory");
            pgx[sc] = (unsigned)(c + 2);
            __builtin_amdgcn_sched_barrier(0);
            { const int cn1 = c + 1 < 256 ? c + 1 : 255; ISSUE_Z(cn1); LORA_LOAD(sf0, cn1, 0); }
            if (c >= 130) { const int ccn = c - 1 < 255 ? c - 1 : 255; while (pgx[sc ^ 1] < (unsigned)(259 - ccn)) __builtin_amdgcn_s_sleep(1); asm volatile("" ::: "memory"); ISSUE_EX(ccn); }
        }
#undef ISSUE_Z
#undef ISSUE_EX
#undef LDC
#undef LD8
#undef PK8
    }
#undef PAIR_PUBLISH
#undef PAIR_WAIT
#undef LORA_LOAD
#undef LORA_MMA
#undef WF_LOAD
    __syncthreads();
}

__device__ __forceinline__ void sgu_phase(LAS unsigned char* lds, const Params& p, const int wv) {
    const int tid = fresh_tid(wv), lane = tid & 63, wave = __builtin_amdgcn_readfirstlane(tid >> 6), kq = lane >> 4, l15 = lane & 15;
    LAS bf16_t* vn = (LAS bf16_t*)lds;
    LAS bf16_t* wsl = (LAS bf16_t*)(lds + 69632);
    constexpr int VS = 264, WSS = 136;
    const bf16_t* V = (const bf16_t*)(p.ws + WS_V); bf16_t* UG = (bf16_t*)(p.ws + WS_UG); const bf16_t* wsb = (const bf16_t*)(p.ws + WS_WS);
    const float* lnsum = (const float*)(p.ws + WS_STATS) + MTOK; const float* lnsq = lnsum + MTOK;
    int cur_g = -1;
    for (int job = blockIdx.x; job < 2048; job += gridDim.x) {
        const int g = job & 15, tok0 = (job >> 4) * 128;
        if (g != cur_g) {
            cur_g = g;
#pragma unroll
            for (int k = 0; k < 4; ++k) { const int qi = tid + 512 * k, row = qi >> 4, c16 = qi & 15;
                *(LAS u32x4*)(wsl + row * WSS + c16 * 8) = *(const u32x4*)(wsb + (size_t)(g * 128 + row) * 128 + c16 * 8); }
        }
        {   const int cc = tid & 31, r0 = tid >> 5, ch = g * 256 + cc * 8;
            const f32x4 ga = *(const f32x4*)(p.in[I_GLNG] + ch), gb = *(const f32x4*)(p.in[I_GLNG] + ch + 4), ba = *(const f32x4*)(p.in[I_GLNB] + ch), bb = *(const f32x4*)(p.in[I_GLNB] + ch + 4);
#pragma unroll
            for (int q = 0; q < 8; ++q) { const int r = r0 + 16 * q, row = tok0 + r;
                const float mean = lnsum[row] * (1.f / BR), var = lnsq[row] * (1.f / BR) - mean * mean, rstd = __builtin_amdgcn_rsqf(fmaxf(var, 0.f) + 1e-5f);
                const u32x4 w = *(const u32x4*)(V + (size_t)row * BR + ch); float x[8]; unpack8(w, x);
#pragma unroll
                for (int e = 0; e < 4; ++e) { x[e] = (x[e] - mean) * rstd * ga[e] + ba[e]; x[4 + e] = (x[4 + e] - mean) * rstd * gb[e] + bb[e]; }
                *(LAS u32x4*)(vn + r * VS + cc * 8) = pack8(x); } }
        u32x2 ugv[8][2];
#pragma unroll
        for (int it = 0; it < 8; ++it)
#pragma unroll
            for (int dt = 0; dt < 2; ++dt) ugv[it][dt] = *(const u32x2*)(UG + (size_t)(tok0 + 16 * it + l15) * BR + g * 256 + 32 * wave + 16 * dt + 4 * kq);
        __syncthreads();
        f32x4 acc[2][8];
#pragma unroll
        for (int dt = 0; dt < 2; ++dt)
#pragma unroll
            for (int it = 0; it < 8; ++it) acc[dt][it] = (f32x4){0.f, 0.f, 0.f, 0.f};
#pragma unroll 1
        for (int ks = 0; ks < 4; ++ks) {
            bf16x8 xf[2];
#pragma unroll
            for (int dt = 0; dt < 2; ++dt)
#pragma unroll
                for (int e = 0; e < 8; ++e) xf[dt][e] = (short)vn[(32 * ks + 8 * kq + e) * VS + 32 * wave + 16 * dt + l15];
#pragma unroll
            for (int it = 0; it < 8; ++it) { const bf16x8 yf = *(const LAS bf16x8*)(wsl + (16 * it + l15) * WSS + 32 * ks + 8 * kq);
#pragma unroll
                for (int dt = 0; dt < 2; ++dt) acc[dt][it] = __builtin_amdgcn_mfma_f32_16x16x32_bf16(xf[dt], yf, acc[dt][it], 0, 0, 0); }
        }
#pragma unroll
        for (int it = 0; it < 8; ++it) { const int ti = 16 * it + l15; const float bs = p.in[I_GBS][g * 128 + ti];
#pragma unroll
            for (int dt = 0; dt < 2; ++dt) { bf16_t* up = UG + (size_t)(tok0 + ti) * BR + g * 256 + 32 * wave + 16 * dt + 4 * kq;
                const u32x2 uw = ugv[it][dt];
                u32x2 o; o.x = pk2(bflo(uw.x) * (acc[dt][it][0] + bs), bfhi(uw.x) * (acc[dt][it][1] + bs)); o.y = pk2(bflo(uw.y) * (acc[dt][it][2] + bs), bfhi(uw.y) * (acc[dt][it][3] + bs));
                *(u32x2*)up = o; } }
        __syncthreads();
    }
}

#define XB_TMO      128
#define XB_XCNT(j)  (256  + 64 * (j))
#define XB_XSUB(j)  (1280 + 64 * (j))
#define XB_XGEN(j)  (2304 + 64 * (j))
#define XB_TOP      3328
#define XB_TOPGEN   3392
#define XCD_BAR_WORDS 3456
#define XB_SPIN_CAP (1u << 18)

__device__ __forceinline__ unsigned xb_ld(unsigned* p)              { return __hip_atomic_load(p, __ATOMIC_RELAXED, __HIP_MEMORY_SCOPE_AGENT); }
__device__ __forceinline__ unsigned xb_add(unsigned* p, unsigned v) { return __hip_atomic_fetch_add(p, v, __ATOMIC_RELAXED, __HIP_MEMORY_SCOPE_AGENT); }
__device__ __forceinline__ unsigned xb_xcc_id() { return (unsigned)__builtin_amdgcn_s_getreg((3 << 11) | 20) & 0xFu; }
#define XB_SPIN(cond, bar) do { unsigned _sp = 0; while (cond) { __builtin_amdgcn_s_sleep(1); \
    if ((++_sp & 255u) == 0u) { if (xb_ld(&(bar)[XB_TMO])) break; if (_sp > XB_SPIN_CAP) { atomicAdd(&(bar)[XB_TMO], 1u); break; } } } } while (0)

struct XcdBarrier {
    unsigned* bar; unsigned x;
    volatile LAS unsigned* st;
};

__device__ __forceinline__ XcdBarrier xcd_barrier_post(unsigned* bar, volatile LAS unsigned* st, int wv) {
    XcdBarrier b; b.bar = bar; b.x = xb_xcc_id(); b.st = st;
    if (wv == 0 && __builtin_amdgcn_mbcnt_hi(~0u, __builtin_amdgcn_mbcnt_lo(~0u, 0u)) == 0u) (void)xb_add(&bar[XB_XCNT(b.x)], 1u);
    return b;
}
__device__ __forceinline__ void xcd_barrier_complete(unsigned* bar, unsigned x, unsigned& nloc, unsigned& nx) {
    const unsigned G = gridDim.x * gridDim.y * gridDim.z;
    unsigned sum, cnt, mine, sp = 0u;
    for (;;) {
        sum = 0u; cnt = 0u; mine = 0u;
#pragma unroll
        for (unsigned j = 0; j < 16; ++j) { const unsigned c = xb_ld(&bar[XB_XCNT(j)]); sum += c; cnt += (c > 0u) ? 1u : 0u; mine = (j == x) ? c : mine; }
        if (sum == G) break;
        __builtin_amdgcn_s_sleep(1);
        if ((++sp & 255u) == 0u) { if (xb_ld(&bar[XB_TMO])) break; if (sp > XB_SPIN_CAP) { atomicAdd(&bar[XB_TMO], 1u); break; } }
    }
    nloc = mine > 0u ? mine : 1u; nx = cnt > 0u ? cnt : 1u;
}

__device__ __forceinline__ void xcd_barrier(const XcdBarrier& b, int wv) {
    asm volatile("s_waitcnt vmcnt(0)" ::: "memory");
    __syncthreads();
    if (wv == 0 && __builtin_amdgcn_mbcnt_hi(~0u, __builtin_amdgcn_mbcnt_lo(~0u, 0u)) == 0u) {
        unsigned* bar = b.bar;
        __builtin_amdgcn_s_waitcnt(0);
        unsigned nloc = b.st[0], nx = b.st[1];
        if (nloc == 0u) { xcd_barrier_complete(bar, b.x, nloc, nx); b.st[0] = nloc; b.st[1] = nx; }
        const unsigned old = xb_add(&bar[XB_XSUB(b.x)], 1u);
        const unsigned gen = old / nloc;
        if (old + 1u == (gen + 1u) * nloc) {
            __builtin_amdgcn_fence(__ATOMIC_RELEASE, "agent");
            asm volatile("s_waitcnt vmcnt(0)" ::: "memory");
            const unsigned og = xb_add(&bar[XB_TOP], 1u);
            const unsigned tg = og / nx;
            if (og + 1u == (tg + 1u) * nx) xb_add(&bar[XB_TOPGEN], 1u);
            else XB_SPIN(xb_ld(&bar[XB_TOPGEN]) == tg, bar);
            __builtin_amdgcn_fence(__ATOMIC_ACQUIRE, "agent");
            xb_add(&bar[XB_XGEN(b.x)], 1u);
            asm volatile("s_waitcnt vmcnt(0)" ::: "memory");
        } else {
            XB_SPIN(xb_ld(&bar[XB_XGEN(b.x)]) == gen, bar);
            __builtin_amdgcn_fence(__ATOMIC_ACQUIRE, "agent");
            asm volatile("s_waitcnt vmcnt(0)" ::: "memory");
        }
    }
    __syncthreads();
}

__device__ __forceinline__ void grid_bar(unsigned* ctr, unsigned target, int wv) {
    __syncthreads();
    if (wv == 0) {
        __builtin_amdgcn_fence(__ATOMIC_RELEASE, "agent");
        if (__builtin_amdgcn_mbcnt_hi(~0u, __builtin_amdgcn_mbcnt_lo(~0u, 0u)) == 0u) {
            __hip_atomic_fetch_add(ctr, 1u, __ATOMIC_RELAXED, __HIP_MEMORY_SCOPE_AGENT);
            while (__hip_atomic_load(ctr, __ATOMIC_RELAXED, __HIP_MEMORY_SCOPE_AGENT) < target) __builtin_amdgcn_s_sleep(1);
        }
        __builtin_amdgcn_fence(__ATOMIC_ACQUIRE, "agent");
    }
    __syncthreads();
}
__global__ void __launch_bounds__(NTHREADS, 2) fwd_kernel(Params p) {
    __builtin_assume(__builtin_amdgcn_workitem_id_y() == 0); __builtin_assume(__builtin_amdgcn_workitem_id_z() == 0);
    extern __shared__ __attribute__((aligned(16))) unsigned char lds_raw[];
    LAS unsigned char* lds = (LAS unsigned char*)lds_raw;
    cg::grid_group grid = cg::this_grid();
    const int wv = __builtin_amdgcn_readfirstlane((int)threadIdx.x >> 6);
    const int G = gridDim.x, NGW = G * NWAVES;
    const size_t NGT = (size_t)G * NTHREADS;
    unsigned char* ws = p.ws;
    float* rstd0 = (float*)(ws + WS_RSTD0); float* stats = (float*)(ws + WS_STATS);
#define PHASE_IDS() const int tid = fresh_tid(wv), lane = tid & 63, wave = __builtin_amdgcn_readfirstlane(tid >> 6); const int gw = blockIdx.x * NWAVES + wave; \
    const size_t gtid = (size_t)blockIdx.x * NTHREADS + tid; LAS float* scr = (LAS float*)(lds + wave * 16384); (void)lane; (void)gw; (void)gtid; (void)scr
    const int lo = p.ph_lo, hi = p.ph_hi;
#define IN(k) (lo <= (k) && (k) < hi)
    unsigned* barctr = (unsigned*)(ws + WS_MISC + 400 * 1024);
    volatile LAS unsigned* xst = (volatile LAS unsigned*)(lds + 149760 + 64);
    if (wv == 0 && __builtin_amdgcn_mbcnt_hi(~0u, __builtin_amdgcn_mbcnt_lo(~0u, 0u)) == 0u) { xst[0] = 0u; xst[1] = 0u; }
    XcdBarrier xb; xb.bar = barctr; xb.x = 0u; xb.st = xst;
#define SEAM(k) do { if (IN(k) && IN((k) + 1)) { if ((k) == 0) { grid.sync(); xb = xcd_barrier_post(barctr, xst, wv); } else xcd_barrier(xb, wv); } } while (0)

    if (IN(0)) {
        PHASE_IDS();
        for (size_t k = gtid; k < 4 * MTOK; k += NGT) stats[k] = 0.f;
        for (size_t k = gtid; k < XCD_BAR_WORDS; k += NGT) barctr[k] = 0u;
        for (int m = gw; m < MTOK; m += NGW) {
            const f32x4* xr = (const f32x4*)(p.in[I_X] + (size_t)m * DM) + lane; f32x4 v[8]; float s = 0.f;
#pragma unroll
            for (int jj = 0; jj < 8; ++jj) { v[jj] = xr[64 * jj]; s += (v[jj][0] * v[jj][0] + v[jj][1] * v[jj][1]) + (v[jj][2] * v[jj][2] + v[jj][3] * v[jj][3]); }
            s = wave_sum(s);
            const float rs0 = 1.f / sqrtf(s * (1.f / DM) + 1e-5f);
            u32x2* o8 = (u32x2*)((bf16_t*)(ws + WS_A0) + (size_t)m * DM) + lane;
#pragma unroll
            for (int jj = 0; jj < 8; ++jj) { u32x2 o; o.x = pk2(v[jj][0] * rs0, v[jj][1] * rs0); o.y = pk2(v[jj][2] * rs0, v[jj][3] * rs0); o8[64 * jj] = o; }
        }
        convert_matrix(p.in[I_RWIN], RIN, DM, N1PAD, (bf16_t*)(ws + WS_WRKV), p.in[I_NG], scr, gw, NGW, lane, [](int n0) { return n0 < SHIFTC ? n0 : -1; });
        {
            u32x4* dst = (u32x4*)(ws + WS_LORA);
            for (size_t it = gtid; it < (size_t)2 * 2 * 64 * 3 * 4 * 64; it += NGT) {
                const int l = (int)(it & 63), nt = (int)((it >> 6) & 3), ks = (int)((it >> 8) % 3), hh = (int)((it / 768) & 63), d = (int)((it / 49152) & 1), mat = (int)(it / 98304);
                const float* up = (mat ? p.in[I_AUP] : p.in[I_WUP]) + (size_t)d * 96 * BR + (size_t)(32 * ks + 8 * (l >> 4)) * BR + 64 * hh + 16 * nt + (l & 15);
                float v[8];
#pragma unroll
                for (int e = 0; e < 8; ++e) v[e] = up[(size_t)e * BR];
                dst[it] = pack8(v); } }
        {   bf16_t* wsb = (bf16_t*)(ws + WS_WS);
            for (size_t k = gtid; k < (size_t)16 * 128 * 128 / 2; k += NGT) { const f32x2 v = *(const f32x2*)(p.in[I_GWS] + 2 * k); ((unsigned*)wsb)[k] = pk2(v.x, v.y); } }
    }
    SEAM(0);
    if (IN(1)) {
        pg8::Gemm g{(const bf16_t*)(ws + WS_A0), (const bf16_t*)(ws + WS_WRKV), MTOK, N1PAD, DM}; pg8::StaticOrder S; S.init(MTOK, N1PAD, G, (int)blockIdx.x);
        EpiZ E{(bf16_t*)(ws + WS_Z), (bf16_t*)(ws + WS_ZL), rstd0};
        pg8::gemm_phase<EpiZ, pg8::StaticOrder, true, true>(lds, g, S, E, wv);
    }
#if defined(REPEAT_PHASE) && REPEAT_PHASE == 1
    if (IN(1)) {
        pg8::Gemm g{(const bf16_t*)(ws + WS_A0), (const bf16_t*)(ws + WS_WRKV), MTOK, N1PAD, DM}; pg8::StaticOrder S; S.init(MTOK, N1PAD, G, (int)blockIdx.x);
        EpiZ E{(bf16_t*)(ws + WS_Z), (bf16_t*)(ws + WS_ZL), rstd0};
        pg8::gemm_phase<EpiZ, pg8::StaticOrder, true, true>(lds, g, S, E, wv);
    }
#endif
    SEAM(1);
    if (IN(2)) {
        PHASE_IDS();
        convert_matrix(p.in[I_RWIN], RIN, DM, BR, (bf16_t*)(ws + WS_WG), p.in[I_NG], scr, gw, NGW, lane, [](int n0) { return SHIFTC + n0; });
        convert_matrix(p.in[I_RWOUT], DM, BR, DM, (bf16_t*)(ws + WS_WO0), nullptr, scr, gw, NGW, lane, [](int n0) { return n0; });
        const bf16_t* ZL = (const bf16_t*)(ws + WS_ZL); bf16_t* ZLP = (bf16_t*)(ws + WS_ZLP);
        for (size_t it = gtid; it < (size_t)MTOK * 48; it += NGT) {
            const int row = (int)(it / 48), c0 = (int)(it % 48) * 8, t = row & (TSEQ - 1);
            const u32x4 z0 = *(const u32x4*)(ZL + (size_t)row * NLORA + c0);
            const u32x4 zm = t > 0 ? *(const u32x4*)(ZL + (size_t)(row - 1) * NLORA + c0) : (u32x4){0u, 0u, 0u, 0u};
            const u32x4 zp = t < TSEQ - 1 ? *(const u32x4*)(ZL + (size_t)(row + 1) * NLORA + c0) : (u32x4){0u, 0u, 0u, 0u};
            float a0[8], am[8], ap[8], o[8]; unpack8(z0, a0); unpack8(zm, am); unpack8(zp, ap);
#pragma unroll
            for (int e = 0; e < 8; ++e) { const float mp = p.in[I_MUP][NRKV + c0 + e], mn = p.in[I_MUN][NRKV + c0 + e];
                const float z = a0[e] + mp * (am[e] - a0[e]) + mn * (ap[e] - a0[e]); o[e] = c0 < 192 ? tanhf_(z) : z; }
            *(u32x4*)(ZLP + (size_t)row * NLORA + c0) = pack8(o);
        }
    }
    SEAM(2);
    if (IN(3)) { for (int pg = blockIdx.x; pg < 256; pg += G) scan_phase(lds, p, pg, wv); }
    SEAM(3);
    if (IN(4)) {
        PHASE_IDS();
        const float* g1 = p.in[I_NG] + DM;
        convert_matrix(p.in[I_GWIN], 3 * BR, DM, 3 * BR, (bf16_t*)(ws + WS_WIN1), g1, scr, gw, NGW, lane, [](int n0) {
            if (n0 >= 2 * BR) return BR + (n0 - 2 * BR);
            const int jj = n0 >> 8, half = (n0 >> 7) & 1, ii = n0 & 127; return (half ? 2 * BR : 0) + 128 * jj + ii; });
        convert_matrix(p.in[I_GWOUT], DM, BR, DM, (bf16_t*)(ws + WS_WO1), nullptr, scr, gw, NGW, lane, [](int n0) { return n0; });
        __syncthreads();
        pg8::Gemm g{(const bf16_t*)(ws + WS_A0), (const bf16_t*)(ws + WS_WG), MTOK, BR, DM}; pg8::StaticOrder S; S.init(MTOK, BR, G, (int)blockIdx.x);
        EpiGate E{(bf16_t*)p.out, rstd0};
        pg8::gemm_phase<EpiGate, pg8::StaticOrder, true, true>(lds, g, S, E, wv);
    }
    SEAM(4);
    if (IN(5)) {
        pg8::Gemm g{(const bf16_t*)p.out, (const bf16_t*)(ws + WS_WO0), MTOK, DM, BR}; pg8::StaticOrder S; S.init(MTOK, DM, G, (int)blockIdx.x);
        EpiH1 E{p.in[I_X], (bf16_t*)(ws + WS_A1), stats};
        pg8::gemm_phase<EpiH1, pg8::StaticOrder, true, true>(lds, g, S, E, wv);
    }
    SEAM(5);
    if (IN(6)) {
        pg8::Gemm g{(const bf16_t*)(ws + WS_A1), (const bf16_t*)(ws + WS_WIN1), MTOK, 3 * BR, DM}; pg8::StaticOrder S; S.init(MTOK, 3 * BR, G, (int)blockIdx.x);
        EpiL1 E{(bf16_t*)(ws + WS_UG), (bf16_t*)(ws + WS_V), stats, stats + MTOK, stats + 2 * MTOK};
        pg8::gemm_phase<EpiL1, pg8::StaticOrder, true, true>(lds, g, S, E, wv);
    }
    SEAM(6);
    if (IN(7)) sgu_phase(lds, p, wv);
    SEAM(7);
    if (IN(8)) {
        pg8::Gemm g{(const bf16_t*)(ws + WS_UG), (const bf16_t*)(ws + WS_WO1), MTOK, DM, BR}; pg8::StaticOrder S; S.init(MTOK, DM, G, (int)blockIdx.x);
        EpiH2 E{(const bf16_t*)(ws + WS_A1), (bf16_t*)(ws + WS_H1), stats + 3 * MTOK};
        pg8::gemm_phase<EpiH2, pg8::StaticOrder, true, true>(lds, g, S, E, wv);
    }
    SEAM(8);
    if (IN(9)) {
        PHASE_IDS();
        const float* ssq = stats + 3 * MTOK; const f32x4* gf = (const f32x4*)p.in[I_FNG] + lane;
        for (int m = gw; m < MTOK; m += 2 * NGW) {
            const int m2 = m + NGW < MTOK ? m + NGW : m;
            const float r = 1.f / sqrtf(ssq[m] * (1.f / DM) + 1e-5f), r2 = 1.f / sqrtf(ssq[m2] * (1.f / DM) + 1e-5f);
            const u32x2* hrow = (const u32x2*)((const bf16_t*)(ws + WS_H1) + (size_t)m * DM) + lane;
            const u32x2* hrow2 = (const u32x2*)((const bf16_t*)(ws + WS_H1) + (size_t)m2 * DM) + lane;
            u32x2 wa[8], wb[8];
#pragma unroll
            for (int jj = 0; jj < 8; ++jj) { wa[jj] = hrow[64 * jj]; wb[jj] = hrow2[64 * jj]; }
            f32x4* orow = (f32x4*)(p.out + (size_t)m * DM) + lane; f32x4* orow2 = (f32x4*)(p.out + (size_t)m2 * DM) + lane;
#pragma unroll
            for (int jj = 0; jj < 8; ++jj) { const f32x4 gv = gf[64 * jj];
                orow[64 * jj] = (f32x4){bflo(wa[jj].x), bfhi(wa[jj].x), bflo(wa[jj].y), bfhi(wa[jj].y)} * r * gv;
                if (m2 != m) orow2[64 * jj] = (f32x4){bflo(wb[jj].x), bfhi(wb[jj].x), bflo(wb[jj].y), bfhi(wb[jj].y)} * r2 * gv; }
        }
    }
}

extern "C" void kernel_launch(void* const* d_in, const int* in_sizes, int n_in, void* d_out, int out_size, void* d_ws, size_t ws_size, hipStream_t stream) {
    static int grid_blocks = 0;
    if (!grid_blocks) {
        int dev = 0, cus = 0, per_cu = 0;
        (void)hipGetDevice(&dev);
        (void)hipDeviceGetAttribute(&cus, hipDeviceAttributeMultiprocessorCount, dev);
        (void)hipFuncSetAttribute((const void*)fwd_kernel, hipFuncAttributeMaxDynamicSharedMemorySize, LDS_BYTES);
        (void)hipOccupancyMaxActiveBlocksPerMultiprocessor(&per_cu, (const void*)fwd_kernel, NTHREADS, LDS_BYTES);
        if (per_cu < 1) per_cu = 1;
        grid_blocks = cus * per_cu;
        if (ws_size < WS_END || n_in != 22) { fprintf(stderr, "kernel_launch: needs %zu bytes of workspace (got %zu), 22 inputs (got %d)\n", (size_t)WS_END, ws_size, n_in); grid_blocks = -1; }
    }
    if (grid_blocks < 0) return;
    Params p{};
    for (int i = 0; i < 22; ++i) p.in[i] = (const float*)d_in[i];
    p.out = (float*)d_out; p.ws = (unsigned char*)d_ws; p.ph_lo = 0; p.ph_hi = 10;
    void* args[] = {&p};
    hipError_t e = hipLaunchCooperativeKernel((void*)fwd_kernel, dim3(grid_blocks), dim3(NTHREADS), args, LDS_BYTES, stream);
    if (e != hipSuccess) fprintf(stderr, "cooperative launch failed: %s (grid %d)\n", hipGetErrorString(e), grid_blocks);
}
```

```cpp
#include <hip/hip_runtime.h>
#include <hip/hip_cooperative_groups.h>
#include <cstdio>
#include <cstdint>
namespace cg = cooperative_groups;

#define GAS __attribute__((address_space(1)))
#define LAS __attribute__((address_space(3)))
typedef unsigned short bf16_t;
typedef short bf16x8 __attribute__((ext_vector_type(8)));
typedef float f32x4 __attribute__((ext_vector_type(4)));
typedef float f32x2 __attribute__((ext_vector_type(2)));
typedef unsigned u32x4 __attribute__((ext_vector_type(4)));
typedef unsigned u32x2 __attribute__((ext_vector_type(2)));

constexpr int NTHREADS = 512, NWAVES = 8;
constexpr int LDS_BYTES = 150528;
constexpr int MTOK = 16384, DM = 2048, BR = 4096, TSEQ = 2048, NB = 8, NH = 64;
constexpr int RIN = 16768, SHIFTC = 12672, NRKV = 12288, NLORA = 384, N1PAD = 12800;
constexpr size_t MiB = 1ull << 20;
constexpr size_t WS_Z = 0;
constexpr size_t WS_ZL = 384 * MiB;
constexpr size_t WS_A0 = 396 * MiB;
constexpr size_t WS_WRKV = 460 * MiB;
constexpr size_t WS_ZLP = 460 * MiB;
constexpr size_t WS_WG = 472 * MiB;
constexpr size_t WS_WO0 = 488 * MiB;
constexpr size_t WS_H1 = 0;
constexpr size_t WS_A1 = 128 * MiB;
constexpr size_t WS_WIN1 = 192 * MiB;
constexpr size_t WS_WO1 = 240 * MiB;
constexpr size_t WS_UG = 256 * MiB;
constexpr size_t WS_V = 384 * MiB;
constexpr size_t WS_MISC = 512 * MiB;
constexpr size_t WS_RSTD0 = WS_MISC;
constexpr size_t WS_STATS = WS_MISC + 65536;
constexpr size_t WS_WS = WS_MISC + 512 * 1024;
constexpr size_t WS_LORA = WS_MISC + 1 * MiB;
constexpr size_t WS_BSC = WS_MISC + 4 * MiB;
constexpr size_t WS_END = WS_MISC + 8 * MiB;

__device__ __forceinline__ unsigned f2bf(float f) { unsigned u = __builtin_bit_cast(unsigned, f); return (u + 0x7fffu + ((u >> 16) & 1u)) >> 16; }
typedef __bf16 bf16x2_t __attribute__((ext_vector_type(2)));
__device__ __forceinline__ unsigned pk2(float lo, float hi) { f32x2 v = {lo, hi}; bf16x2_t b = __builtin_convertvector(v, bf16x2_t); return __builtin_bit_cast(unsigned, b); }
__device__ __forceinline__ float bflo(unsigned w) { return __builtin_bit_cast(float, w << 16); }
__device__ __forceinline__ float bfhi(unsigned w) { return __builtin_bit_cast(float, w & 0xffff0000u); }
__device__ __forceinline__ void unpack8(u32x4 w, float* o) { o[0] = bflo(w.x); o[1] = bfhi(w.x); o[2] = bflo(w.y); o[3] = bfhi(w.y); o[4] = bflo(w.z); o[5] = bfhi(w.z); o[6] = bflo(w.w); o[7] = bfhi(w.w); }
__device__ __forceinline__ u32x4 pack8(const float* v) { u32x4 w; w.x = pk2(v[0], v[1]); w.y = pk2(v[2], v[3]); w.z = pk2(v[4], v[5]); w.w = pk2(v[6], v[7]); return w; }
__device__ __forceinline__ float fexp(float x) { return __builtin_amdgcn_exp2f(x * 1.4426950408889634f); }
__device__ __forceinline__ float frcp(float x) { return __builtin_amdgcn_rcpf(x); }
__device__ __forceinline__ float sigmoidf_(float x) { return frcp(1.f + fexp(-x)); }
__device__ __forceinline__ float siluf_(float x) { return x * sigmoidf_(x); }
__device__ __forceinline__ float geluf_(float x) { const float u = 1.5957691216057308f * (x + 0.044715f * x * x * x); return x * sigmoidf_(u); }
__device__ __forceinline__ float tanhf_(float x) { return 1.f - 2.f * frcp(1.f + fexp(2.f * x)); }
__device__ __forceinline__ float wave_sum(float v) {
#pragma unroll
    for (int o = 1; o < 64; o <<= 1) v += __shfl_xor(v, o);
    return v;
}
template <int CTRL> __device__ __forceinline__ float dppf(float v) { return __builtin_bit_cast(float, __builtin_amdgcn_update_dpp(0, __builtin_bit_cast(int, v), CTRL, 0xf, 0xf, true)); }
__device__ __forceinline__ float quad_sum(float v) { v += dppf<0xB1>(v); v += dppf<0x4E>(v); return v; }
__device__ __forceinline__ float oct_sum(float v) { v = quad_sum(v); v += dppf<0x141>(v); return v; }

namespace pg8 {
#define PG8_LAS __attribute__((address_space(3)))
constexpr int BM = 256, BK = 64, HALF = 128, HTB = HALF * BK * 2, STAGE_BYTES = 8 * HTB, NXCD = 8, WGM = 8;
__host__ __device__ __forceinline__ int lds_byte(int r, int c) { const int st = (r >> 4) * 2 + (c >> 5), rr = r & 15, cc = c & 31, ob = rr * 64 + cc * 2; return st * 1024 + (ob ^ (((ob >> 9) & 1) << 5)); }
__host__ __device__ __forceinline__ void stage_rc(int b, int& R, int& C) { const int st = b / 1024, sb = b % 1024, swz = sb ^ (((sb >> 9) & 1) << 5); R = (st >> 1) * 16 + swz / 64; C = (st & 1) * 32 + (swz % 64) / 2; }
__host__ __device__ __forceinline__ int perm32(int rho) { const int n = rho >> 4, i = rho & 15; return 8 * (i >> 2) + 4 * n + (i & 3); }
struct Unit { int pm, pn; };
struct Gemm { const bf16_t* A; const bf16_t* Bt; int M, N, K; };
struct StaticOrder {
    int nM, nN, nwg, G, c;
    __host__ __device__ void init(int M, int N, int G_, int c_) { nM = M / BM; nN = N / BM; nwg = nM * nN; G = G_; c = c_; }
    __host__ __device__ bool next(int i, Unit& u) const {
        const long L = (long)i * G + c; if (L >= nwg) return false;
        int wgid = (int)L; { const int q = nwg / NXCD, r = nwg % NXCD, xcd = wgid % NXCD, off = wgid / NXCD; wgid = (xcd < r ? xcd * (q + 1) : r * (q + 1) + (xcd - r) * q) + off; }
        const int nig = WGM * nN, gid = wgid / nig, fm = gid * WGM, gsz = (nM - fm) < WGM ? (nM - fm) : WGM;
        u.pm = fm + ((wgid % nig) % gsz); u.pn = (wgid % nig) / gsz; return true;
    }
    __device__ __forceinline__ void a_ready(const Unit&) const {}
    __device__ __forceinline__ void done(const Unit&) const {}
};
template <class Epi, class Sched, bool ALIGN_EPI = false, bool SP2 = false>
__device__ __forceinline__ void gemm_phase(PG8_LAS unsigned char* lds, const Gemm g, const Sched& S, const Epi& E, const int wv) {
    const int wid = wv, lane = (int)__builtin_amdgcn_mbcnt_hi(~0u, __builtin_amdgcn_mbcnt_lo(~0u, 0u)), tid = wid * 64 + lane, wr = wid >> 2, wc = wid & 3, fr = lane & 15, fq = lane >> 4;
    const int K = g.K, nt = K / BK;
    unsigned voffA[2], voffB[2];
#pragma unroll
    for (int i = 0; i < 2; ++i) { int R, C; stage_rc(tid * 16 + i * 8192, R, C); const int Rb = Epi::PERM ? ((R & ~31) + perm32(R & 31)) : R;
        voffA[i] = (unsigned)(R * K + C) * 2u; voffB[i] = (unsigned)(Rb * K + C) * 2u; }
    const size_t kstep = (size_t)(BK * 2);
    const size_t hstep = (size_t)HALF * K * 2;
    const size_t tstep = 2 * hstep;
    const unsigned ldsw = (unsigned)wid * 1024u;
    const int aoff = lds_byte(wr * 64 + fr, fq * 8), boff = lds_byte(wc * 32 + fr, fq * 8);
#define PG8_SA(b, h) (((b) * 2 + (h)) * HTB)
#define PG8_SB(b, h) ((4 + (b) * 2 + (h)) * HTB)
#define PG8_STAGE(bufoff, gbase, voff) do { _Pragma("unroll") for (int _i = 0; _i < 2; ++_i) \
        __builtin_amdgcn_global_load_lds((const unsigned*)((const char*)(gbase) + (voff)[_i]), (PG8_LAS unsigned*)(lds + (bufoff) + ldsw + _i * 8192), 16, 0, 0); } while (0)
#define PG8_LDA(dst, b, h) do { _Pragma("unroll") for (int m = 0; m < 4; ++m) _Pragma("unroll") for (int k = 0; k < 2; ++k) dst[m][k] = *(const PG8_LAS bf16x8*)(lds + PG8_SA(b, h) + aoff + m * 2048 + k * 1024); } while (0)
#define PG8_LDB(dst, b, h) do { _Pragma("unroll") for (int n = 0; n < 2; ++n) _Pragma("unroll") for (int k = 0; k < 2; ++k) dst[n][k] = *(const PG8_LAS bf16x8*)(lds + PG8_SB(b, h) + boff + n * 2048 + k * 1024); } while (0)
#define PG8_MMA(ai, bj, At, Bt) do { __builtin_amdgcn_s_setprio(1); _Pragma("unroll") for (int m = 0; m < 4; ++m) _Pragma("unroll") for (int n = 0; n < 2; ++n) _Pragma("unroll") for (int k = 0; k < 2; ++k) \
        acc[ai][bj][m][n] = __builtin_amdgcn_mfma_f32_16x16x32_bf16(Bt[n][k], At[m][k], acc[ai][bj][m][n], 0, 0, 0); __builtin_amdgcn_s_setprio(0); } while (0)
#define PG8_WAIT_V(n) asm volatile("s_waitcnt vmcnt(" #n ")" ::: "memory")
#define PG8_WAIT_L(n) asm volatile("s_waitcnt lgkmcnt(" #n ")" ::: "memory")
#define PG8_BAR __builtin_amdgcn_s_barrier()
#define PG8_SCHED __builtin_amdgcn_sched_barrier(0)
    Unit cur, nxt; int ui = 0;
    if (!S.next(0, cur)) return;
    f32x4 acc[2][2][4][2];
#pragma unroll
    for (int a = 0; a < 2; ++a)
#pragma unroll
        for (int b = 0; b < 2; ++b)
#pragma unroll
            for (int m = 0; m < 4; ++m)
#pragma unroll
                for (int n = 0; n < 2; ++n) acc[a][b][m][n] = (f32x4){0.f, 0.f, 0.f, 0.f};
    bf16x8 At[4][2], B0[2][2], B1[2][2];
    const char* cA = (const char*)g.A + (size_t)cur.pm * tstep; const char* cB = (const char*)g.Bt + (size_t)cur.pn * tstep;
    S.a_ready(cur);
    if constexpr (SP2) {
        PG8_STAGE(PG8_SB(0, 0), cB, voffB); PG8_STAGE(PG8_SB(0, 1), cB + hstep, voffB); PG8_STAGE(PG8_SA(0, 0), cA, voffA); PG8_STAGE(PG8_SA(0, 1), cA + hstep, voffA);
        if (wr == 1) PG8_BAR;
        PG8_WAIT_V(2); PG8_BAR;
        PG8_STAGE(PG8_SB(1, 0), cB + kstep, voffB); PG8_STAGE(PG8_SA(1, 0), cA + kstep, voffA); PG8_STAGE(PG8_SB(1, 1), cB + hstep + kstep, voffB);
        PG8_WAIT_V(6); PG8_BAR;
    } else {
        PG8_STAGE(PG8_SB(0, 0), cB, voffB); PG8_STAGE(PG8_SA(0, 0), cA, voffA); PG8_STAGE(PG8_SB(0, 1), cB + hstep, voffB); PG8_STAGE(PG8_SA(0, 1), cA + hstep, voffA);
        if (wr == 1) PG8_BAR;
        PG8_WAIT_V(4); PG8_BAR;
        PG8_STAGE(PG8_SB(1, 0), cB + kstep, voffB); PG8_STAGE(PG8_SA(1, 0), cA + kstep, voffA); PG8_STAGE(PG8_SB(1, 1), cB + hstep + kstep, voffB);
        PG8_WAIT_V(6); PG8_BAR;
    }
    for (;;) {
        const bool has_next = S.next(ui + 1, nxt);
        const char* nA = has_next ? (const char*)g.A + (size_t)nxt.pm * tstep : cA; const char* nB = has_next ? (const char*)g.Bt + (size_t)nxt.pn * tstep : cB;
        for (int t = 0; t < nt; t += 2) {
            const bool last = (t == nt - 2);
            const char* a1 = cA + (size_t)(t + 1) * kstep;
            const char* a2 = last ? nA : cA + (size_t)(t + 2) * kstep; const char* b2 = last ? nB : cB + (size_t)(t + 2) * kstep;
            const char* a3 = a2 + kstep; const char* b3 = b2 + kstep;
            if (last && has_next) S.a_ready(nxt);
            if constexpr (SP2) {
            PG8_LDB(B0, 0, 0); PG8_LDB(B1, 0, 1); PG8_SCHED; PG8_LDA(At, 0, 0); PG8_STAGE(PG8_SA(1, 1), a1 + hstep, voffA);
            PG8_WAIT_V(8); PG8_WAIT_L(0); PG8_BAR; PG8_MMA(0, 0, At, B0); PG8_MMA(0, 1, At, B1); PG8_BAR; PG8_SCHED;
            PG8_LDA(At, 0, 1); PG8_STAGE(PG8_SB(0, 0), b2, voffB); PG8_STAGE(PG8_SB(0, 1), b2 + hstep, voffB); PG8_STAGE(PG8_SA(0, 0), a2, voffA);
            PG8_WAIT_V(8); PG8_WAIT_L(0); PG8_BAR; PG8_MMA(1, 0, At, B0); PG8_MMA(1, 1, At, B1); PG8_BAR; PG8_SCHED;
            PG8_LDB(B0, 1, 0); PG8_LDB(B1, 1, 1); PG8_SCHED; PG8_LDA(At, 1, 0); PG8_STAGE(PG8_SA(0, 1), a2 + hstep, voffA);
            PG8_WAIT_V(8); PG8_WAIT_L(0); PG8_BAR; PG8_MMA(0, 0, At, B0); PG8_MMA(0, 1, At, B1); PG8_BAR; PG8_SCHED;
            PG8_LDA(At, 1, 1); PG8_STAGE(PG8_SB(1, 0), b3, voffB); PG8_STAGE(PG8_SB(1, 1), b3 + hstep, voffB); PG8_STAGE(PG8_SA(1, 0), a3, voffA);
            PG8_WAIT_V(8); PG8_WAIT_L(0); PG8_BAR; PG8_MMA(1, 0, At, B0); PG8_MMA(1, 1, At, B1); PG8_BAR; PG8_SCHED;
            } else {
            PG8_LDB(B0, 0, 0); PG8_SCHED; PG8_LDA(At, 0, 0); PG8_STAGE(PG8_SA(1, 1), a1 + hstep, voffA);
            PG8_WAIT_L(8); PG8_BAR; PG8_WAIT_L(0); PG8_MMA(0, 0, At, B0); PG8_BAR; PG8_SCHED;
            PG8_LDB(B1, 0, 1); PG8_STAGE(PG8_SB(0, 0), b2, voffB);
            PG8_BAR; PG8_WAIT_L(0); PG8_MMA(0, 1, At, B1); PG8_BAR;
            PG8_LDA(At, 0, 1); PG8_STAGE(PG8_SA(0, 0), a2, voffA);
            PG8_BAR; PG8_WAIT_L(0); PG8_MMA(1, 0, At, B0); PG8_BAR; PG8_SCHED;
            PG8_STAGE(PG8_SB(0, 1), b2 + hstep, voffB);
            PG8_WAIT_V(6); PG8_BAR; PG8_MMA(1, 1, At, B1); PG8_BAR;
            PG8_LDB(B0, 1, 0); PG8_SCHED; PG8_LDA(At, 1, 0); PG8_STAGE(PG8_SA(0, 1), a2 + hstep, voffA);
            PG8_WAIT_L(8); PG8_BAR; PG8_WAIT_L(0); PG8_MMA(0, 0, At, B0); PG8_BAR; PG8_SCHED;
            PG8_LDB(B1, 1, 1); PG8_STAGE(PG8_SB(1, 0), b3, voffB);
            PG8_BAR; PG8_WAIT_L(0); PG8_MMA(0, 1, At, B1); PG8_BAR;
            PG8_LDA(At, 1, 1); PG8_STAGE(PG8_SA(1, 0), a3, voffA);
            PG8_BAR; PG8_WAIT_L(0); PG8_MMA(1, 0, At, B0); PG8_BAR; PG8_SCHED;
            PG8_STAGE(PG8_SB(1, 1), b3 + hstep, voffB);
            PG8_WAIT_V(6); PG8_BAR; PG8_MMA(1, 1, At, B1); PG8_BAR;
            }
        }
        if constexpr (ALIGN_EPI) { if (wr == 0) PG8_BAR; }
        if constexpr (!Epi::AFTER_DRAIN) { E(acc, cur, wr, wc, fr, fq); S.done(cur); }
        if (!has_next) break;
#pragma unroll
        for (int a = 0; a < 2; ++a)
#pragma unroll
            for (int b = 0; b < 2; ++b)
#pragma unroll
                for (int m = 0; m < 4; ++m)
#pragma unroll
                    for (int n = 0; n < 2; ++n) acc[a][b][m][n] = (f32x4){0.f, 0.f, 0.f, 0.f};
        cur = nxt; cA = nA; cB = nB; ++ui;
        if constexpr (ALIGN_EPI) { if (wr == 1) PG8_BAR; }
    }
    PG8_WAIT_V(0);
    if constexpr (!ALIGN_EPI) { if (wr == 0) PG8_BAR; }
    PG8_BAR;
    if constexpr (Epi::AFTER_DRAIN) { E.fused(acc, cur, wr, wc, fr, fq, lds, wid, lane); S.done(cur); }
#undef PG8_SA
#undef PG8_SB
#undef PG8_STAGE
#undef PG8_LDA
#undef PG8_LDB
#undef PG8_MMA
#undef PG8_WAIT_V
#undef PG8_WAIT_L
#undef PG8_BAR
#undef PG8_SCHED
}
}
using pg8::Unit;
#define LDS_WAIT() asm volatile("s_waitcnt lgkmcnt(0)" ::: "memory")
typedef const f32x4 (&AccRef)[2][2][4][2];
__device__ __forceinline__ void fmac_s(float& acc, float a, float b) { asm("v_fmac_f32 %0, %1, %2" : "+v"(acc) : "v"(a), "v"(b)); }
__device__ __forceinline__ int fresh_tid(int wv) { int t = wv * 64 + (int)__builtin_amdgcn_mbcnt_hi(~0u, __builtin_amdgcn_mbcnt_lo(~0u, 0u)); asm volatile("" : "+v"(t)); return t; }

struct Params { const float* in[22]; float* out; unsigned char* ws; int ph_lo, ph_hi; };
enum { I_X = 0, I_NG, I_FNG, I_RWIN, I_MUP, I_MUN, I_W0, I_WUP, I_A0, I_AUP, I_KK, I_KA, I_RK, I_LNW, I_LNB, I_RWOUT, I_GWIN, I_GLNG, I_GLNB, I_GWS, I_GBS, I_GWOUT };

struct EpiZ {
    static constexpr bool PERM = true, AFTER_DRAIN = false;
    bf16_t* Z; bf16_t* ZL; const float* rstd;
    __device__ __forceinline__ void operator()(AccRef acc, const Unit& u, int wr, int wc, int fr, int fq) const {
        const int row0 = u.pm * 256 + wr * 64 + fr, colb = u.pn * 256 + wc * 32 + 8 * fq;
#pragma unroll
        for (int ai = 0; ai < 2; ++ai)
#pragma unroll
            for (int m = 0; m < 4; ++m) { const int row = row0 + ai * 128 + m * 16;
#pragma unroll
                for (int bj = 0; bj < 2; ++bj) { const int col = colb + bj * 128;
                    const f32x4 v0 = acc[ai][bj][m][0], v1 = acc[ai][bj][m][1];
                    u32x4 w; w.x = pk2(v0[0], v0[1]); w.y = pk2(v0[2], v0[3]); w.z = pk2(v1[0], v1[1]); w.w = pk2(v1[2], v1[3]);
                    if (col < NRKV) *(u32x4*)(Z + (size_t)row * NRKV + col) = w;
                    else if (col < SHIFTC) *(u32x4*)(ZL + (size_t)row * NLORA + (col - NRKV)) = w; } }
    }
};
struct EpiGate {
    static constexpr bool PERM = true, AFTER_DRAIN = false;
    bf16_t* O; const float* rstd;
    __device__ __forceinline__ void operator()(AccRef acc, const Unit& u, int wr, int wc, int fr, int fq) const {
        const int row0 = u.pm * 256 + wr * 64 + fr, colb = u.pn * 256 + wc * 32 + 8 * fq;
#pragma unroll
        for (int ai = 0; ai < 2; ++ai)
#pragma unroll
            for (int m = 0; m < 4; ++m) { const int row = row0 + ai * 128 + m * 16;
#pragma unroll
                for (int bj = 0; bj < 2; ++bj) { bf16_t* op = O + (size_t)row * BR + colb + bj * 128;
                    const u32x4 ow = *(const u32x4*)op; float o[8]; unpack8(ow, o);
                    const f32x4 g0 = acc[ai][bj][m][0], g1 = acc[ai][bj][m][1];
#pragma unroll
                    for (int e = 0; e < 4; ++e) { o[e] *= siluf_(g0[e]); o[4 + e] *= siluf_(g1[e]); }
                    *(u32x4*)op = pack8(o); } }
    }
};
struct EpiH1 {
    static constexpr bool PERM = true, AFTER_DRAIN = false;
    const float* X; bf16_t* A; float* sumsq;
    __device__ __forceinline__ void operator()(AccRef acc, const Unit& u, int wr, int wc, int fr, int fq) const {
        const int row0 = u.pm * 256 + wr * 64 + fr, colb = u.pn * 256 + wc * 32 + 8 * fq;
#pragma unroll
        for (int ai = 0; ai < 2; ++ai)
#pragma unroll
            for (int m = 0; m < 4; ++m) { const int row = row0 + ai * 128 + m * 16; float ss = 0.f;
#pragma unroll
                for (int bj = 0; bj < 2; ++bj) { const size_t off = (size_t)row * DM + colb + bj * 128;
                    const f32x4 h0 = *(const f32x4*)(X + off) + acc[ai][bj][m][0], h1 = *(const f32x4*)(X + off + 4) + acc[ai][bj][m][1];
                    u32x4 w; w.x = pk2(h0[0], h0[1]); w.y = pk2(h0[2], h0[3]); w.z = pk2(h1[0], h1[1]); w.w = pk2(h1[2], h1[3]); *(u32x4*)(A + off) = w;
                    ss += (h0[0] * h0[0] + h0[1] * h0[1]) + (h0[2] * h0[2] + h0[3] * h0[3]) + (h1[0] * h1[0] + h1[1] * h1[1]) + (h1[2] * h1[2] + h1[3] * h1[3]); }
                ss += __shfl_xor(ss, 16); ss += __shfl_xor(ss, 32);
                if (fq == 0) atomicAdd(sumsq + row, ss); }
    }
};
struct EpiH2 {
    static constexpr bool PERM = true, AFTER_DRAIN = false;
    const bf16_t* X; bf16_t* H; float* sumsq;
    __device__ __forceinline__ void operator()(AccRef acc, const Unit& u, int wr, int wc, int fr, int fq) const {
        const int row0 = u.pm * 256 + wr * 64 + fr, colb = u.pn * 256 + wc * 32 + 8 * fq;
#pragma unroll
        for (int ai = 0; ai < 2; ++ai)
#pragma unroll
            for (int m = 0; m < 4; ++m) { const int row = row0 + ai * 128 + m * 16; float ss = 0.f;
#pragma unroll
                for (int bj = 0; bj < 2; ++bj) { const size_t off = (size_t)row * DM + colb + bj * 128;
                    float x[8]; unpack8(*(const u32x4*)(X + off), x);
                    const f32x4 a0 = acc[ai][bj][m][0], a1 = acc[ai][bj][m][1];
                    float hv[8];
#pragma unroll
                    for (int e = 0; e < 4; ++e) { hv[e] = x[e] + a0[e]; hv[4 + e] = x[4 + e] + a1[e]; }
                    *(u32x4*)(H + off) = pack8(hv);
#pragma unroll
                    for (int e = 0; e < 8; ++e) ss += hv[e] * hv[e]; }
                ss += __shfl_xor(ss, 16); ss += __shfl_xor(ss, 32);
                if (fq == 0) atomicAdd(sumsq + row, ss); }
    }
};
struct EpiL1 {
    static constexpr bool PERM = true, AFTER_DRAIN = false;
    bf16_t* UG; bf16_t* V; const float* sumsq1; float* lnsum; float* lnsq;
    __device__ __forceinline__ void operator()(AccRef acc, const Unit& u, int wr, int wc, int fr, int fq) const {
        const int row0 = u.pm * 256 + wr * 64 + fr;
#pragma unroll
        for (int ai = 0; ai < 2; ++ai)
#pragma unroll
            for (int m = 0; m < 4; ++m) { const int row = row0 + ai * 128 + m * 16; const float rs = __builtin_amdgcn_rsqf(sumsq1[row] * (1.f / DM) + 1e-5f);
                if (u.pn < 32) { const int ch = u.pn * 128 + wc * 32 + 8 * fq; float o[8];
#pragma unroll
                    for (int n = 0; n < 2; ++n)
#pragma unroll
                        for (int e = 0; e < 4; ++e) o[4 * n + e] = geluf_(acc[ai][0][m][n][e] * rs) * siluf_(acc[ai][1][m][n][e] * rs);
                    *(u32x4*)(UG + (size_t)row * BR + ch) = pack8(o);
                } else { float s = 0.f, s2 = 0.f;
#pragma unroll
                    for (int bj = 0; bj < 2; ++bj) { const int ch = (u.pn - 32) * 256 + bj * 128 + wc * 32 + 8 * fq; float o[8];
#pragma unroll
                        for (int n = 0; n < 2; ++n)
#pragma unroll
                            for (int e = 0; e < 4; ++e) { const float g = geluf_(acc[ai][bj][m][n][e] * rs); o[4 * n + e] = g; s += g; s2 += g * g; }
                        *(u32x4*)(V + (size_t)row * BR + ch) = pack8(o); }
                    s += __shfl_xor(s, 16); s += __shfl_xor(s, 32); s2 += __shfl_xor(s2, 16); s2 += __shfl_xor(s2, 32);
                    if (fq == 0) { atomicAdd(lnsum + row, s); atomicAdd(lnsq + row, s2); } } }
    }
};

__device__ __forceinline__ void transpose_load(float (&v)[32], const float* W, int ldw, const float* g, int k0, int scol0, int lane) {
    if (scol0 >= 0) { const float* src = W + (size_t)(k0 + (lane >> 5)) * ldw + scol0 + (lane & 31);
#pragma unroll
        for (int i = 0; i < 32; ++i) v[i] = src[(size_t)(2 * i) * ldw];
        if (g) { const float* gp = g + k0 + (lane >> 5);
#pragma unroll
            for (int i = 0; i < 32; ++i) v[i] *= gp[2 * i]; }
    } else {
#pragma unroll
        for (int i = 0; i < 32; ++i) v[i] = 0.f; }
}
__device__ __forceinline__ void transpose_store(const float (&v)[32], int K, bf16_t* WT, LAS float* scr, int k0, int drow0, int lane) {
#pragma unroll
    for (int i = 0; i < 32; ++i) scr[(2 * i + (lane >> 5)) * 33 + (lane & 31)] = v[i];
    LDS_WAIT();
    const int c = lane & 7;
#pragma unroll
    for (int j = 0; j < 4; ++j) { const int n = (lane >> 3) + 8 * j; const LAS float* s = scr + (8 * c) * 33 + n;
        u32x4 o; o.x = pk2(s[0 * 33], s[1 * 33]); o.y = pk2(s[2 * 33], s[3 * 33]); o.z = pk2(s[4 * 33], s[5 * 33]); o.w = pk2(s[6 * 33], s[7 * 33]);
        *(u32x4*)(WT + (size_t)(drow0 + n) * K + k0 + 8 * c) = o; }
    LDS_WAIT();
}
template <class CM> __device__ __forceinline__ void convert_matrix(const float* W, int ldw, int K, int nrows, bf16_t* WT, const float* g, LAS float* scr, int gw, int NGW, int lane, CM colmap) {
    const int nblk = nrows / 32, nitems = (K / 64) * nblk;
    int it = gw;
    if (it >= nitems) return;
    float va[32], vb[32];
    transpose_load(va, W, ldw, g, 64 * (it / nblk), colmap(32 * (it % nblk)), lane);
    for (;;) {
        const int it1 = it + NGW;
        if (it1 < nitems) transpose_load(vb, W, ldw, g, 64 * (it1 / nblk), colmap(32 * (it1 % nblk)), lane);
        transpose_store(va, K, WT, scr, 64 * (it / nblk), 32 * (it % nblk), lane);
        if (it1 >= nitems) break;
        const int it2 = it1 + NGW;
        if (it2 < nitems) transpose_load(va, W, ldw, g, 64 * (it2 / nblk), colmap(32 * (it2 % nblk)), lane);
        transpose_store(vb, K, WT, scr, 64 * (it1 / nblk), 32 * (it1 % nblk), lane);
        if (it2 >= nitems) break;
        it = it2;
    }
}

constexpr int SCN = 37440;
constexpr int SI_X = 0, SI_H = 2304, SI_T = 4608, SI_V = 6656, SI_G7 = 8704, SI_SZ = 8960;
constexpr int SO_GT = 17920, SO_P = 18944, SO_UV = 20992, SO_Y = 23040, SO_L0 = 27136, SO_L1 = 29184, SO_C = 33280, SO_B = 37376;
static_assert(4 * SCN <= LDS_BYTES, "scan LDS");
constexpr int XS = 72;

#define WG_BAR() do { asm volatile("s_waitcnt lgkmcnt(0)" ::: "memory"); __builtin_amdgcn_s_barrier(); asm volatile("" ::: "memory"); } while (0)
__device__ __forceinline__ void scan_phase(LAS unsigned char* lds, const Params& p, const int pg, const int wv) {
    const int tid = fresh_tid(wv), lane = tid & 63, wave = __builtin_amdgcn_readfirstlane(tid >> 6);
    const int sc = wave & 3, role = wave >> 2, pair = sc >> 1, dir = sc & 1;
    const int bh = 2 * pg + pair, b = bh >> 6, h = bh & 63;
    LAS unsigned char* base = lds + sc * SCN;
    LAS float* GT = (LAS float*)(base + SO_GT);
    LAS float* Ps = (LAS float*)(base + SO_P);
    LAS bf16_t* UV = (LAS bf16_t*)(base + SO_UV);
    LAS float* yb = (LAS float*)(base + SO_Y);
    LAS float* lsc0 = (LAS float*)(base + SO_L0);
    LAS float* lsc1 = (LAS float*)(base + SO_L1);
    LAS float* cst = (LAS float*)(base + SO_C);
    LAS float* bon = (LAS float*)(base + SO_B);
    const int sn = lane & 7, kq = lane >> 4;
    const bf16_t* ZLb = (const bf16_t*)(p.ws + WS_ZLP) + (size_t)b * TSEQ * NLORA + dir * 96 + kq * 8;
    const bf16x8* lwu = (const bf16x8*)(p.ws + WS_LORA) + (size_t)(((((role == 0 ? 1 : 0) * 2 + dir) * 64 + h) * 12)) * 64;
    const unsigned ulane = (unsigned)lane;
#define WF_LOAD(w) do { unsigned _ul = ulane; asm volatile("" : "+v"(_ul));     \
        _Pragma("unroll") for (int ks = 0; ks < 3; ++ks) _Pragma("unroll") for (int nt = 0; nt < 4; ++nt) w[ks][nt] = lwu[(unsigned)((ks * 4 + nt) * 64) + _ul]; } while (0)
#define LORA_LOAD(sfv, cn, mat) do { const int _ts = dir ? (2047 - 8 * (cn) - sn) : (8 * (cn) + sn); \
        _Pragma("unroll") for (int ks = 0; ks < 3; ++ks) sfv[ks] = *(const bf16x8*)(ZLb + (size_t)_ts * NLORA + (mat) * 192 + ks * 32); } while (0)
#define LORA_MMA(wfv, sfv, dstp) do { _Pragma("unroll") for (int nt = 0; nt < 4; ++nt) { f32x4 _acc = (f32x4){0.f, 0.f, 0.f, 0.f}; \
        _Pragma("unroll") for (int ks = 0; ks < 3; ++ks) _acc = __builtin_amdgcn_mfma_f32_16x16x32_bf16(wfv[ks][nt], sfv[ks], _acc, 0, 0, 0); \
        if ((lane & 15) < 8) *(LAS f32x4*)((dstp) + (lane & 15) * 64 + 16 * nt + 4 * kq) = _acc; } } while (0)
    volatile LAS unsigned* pgall = (volatile LAS unsigned*)(lds + 149760 + 128);
    if (tid < 8) pgall[tid] = 0u;
    __syncthreads();
    volatile LAS unsigned* pgm = pgall + 2 * sc;
    volatile LAS unsigned* pgo = pgall + 2 * (sc ^ 1);
#define PAIR_SYNC(c) do { asm volatile("s_waitcnt lgkmcnt(0)" ::: "memory"); pgm[role] = (unsigned)(c) + 1u; \
        while (pgm[role ^ 1] < (unsigned)(c) + 1u) __builtin_amdgcn_s_sleep(3);        asm volatile("" ::: "memory"); } while (0)
    if (role == 0) {
        __builtin_amdgcn_s_setprio(1);
        const int n = lane & 15, q = lane >> 4;
        f32x4 Sacc[4][4];
#pragma unroll
        for (int mt = 0; mt < 4; ++mt)
#pragma unroll
            for (int nt = 0; nt < 4; ++nt) Sacc[mt][nt] = (f32x4){0.f, 0.f, 0.f, 0.f};
        bf16x8 w1[3][4], sf1[3];
        WF_LOAD(w1); LORA_LOAD(sf1, 0, 1); LORA_MMA(w1, sf1, lsc1);
        WF_LOAD(w1); LORA_LOAD(sf1, 1, 1);
        for (int c = 0; c < 258; ++c) {
            PAIR_SYNC(c);
            if (c + 1 < 256) LORA_MMA(w1, sf1, lsc1 + ((c + 1) & 1) * 512);
            __builtin_amdgcn_sched_barrier(0);
            if (c >= 1 && c <= 256) {
                const int cc = c - 1;
                const LAS unsigned char* in = base + (cc & 1) * SI_SZ;
                const LAS bf16_t* Xs = (const LAS bf16_t*)(in + SI_X); const LAS bf16_t* Hs = (const LAS bf16_t*)(in + SI_H); const LAS bf16_t* Tk = (const LAS bf16_t*)(in + SI_T);
                const LAS float* vb = (const LAS float*)(in + SI_V); const LAS float* g7 = (const LAS float*)(in + SI_G7);
                LAS float* yq = yb + (cc & 1) * 512;
                { f32x4 G = (f32x4){0.f, 0.f, 0.f, 0.f};
#pragma unroll
                  for (int ks = 0; ks < 2; ++ks) { const bf16x8 hf = *(const LAS bf16x8*)(Hs + n * XS + 32 * ks + 8 * q), xf = *(const LAS bf16x8*)(Xs + n * XS + 32 * ks + 8 * q);
                      G = __builtin_amdgcn_mfma_f32_16x16x32_bf16(hf, xf, G, 0, 0, 0); }
                  *(LAS f32x4*)(GT + n * 16 + 4 * q) = G; }
                __builtin_amdgcn_sched_barrier(0);
                { bf16x8 xp[2];
#pragma unroll
                  for (int ks = 0; ks < 2; ++ks) { const u32x2 lo = *(const LAS u32x2*)(Xs + n * XS + 32 * ks + 4 * q), hi = *(const LAS u32x2*)(Xs + n * XS + 32 * ks + 16 + 4 * q);
                      const u32x4 w = (u32x4){lo.x, lo.y, hi.x, hi.y}; xp[ks] = __builtin_bit_cast(bf16x8, w); }
#pragma unroll
                  for (int nt = 0; nt < 4; ++nt) { f32x4 acc = (f32x4){0.f, 0.f, 0.f, 0.f}; __builtin_amdgcn_sched_barrier(0);
#pragma unroll
                      for (int ks = 0; ks < 2; ++ks) { const f32x4 s0 = Sacc[2 * ks][nt], s1 = Sacc[2 * ks + 1][nt];
                          const u32x4 w = (u32x4){pk2(s0[0], s0[1]), pk2(s0[2], s0[3]), pk2(s1[0], s1[1]), pk2(s1[2], s1[3])};
                          acc = __builtin_amdgcn_mfma_f32_16x16x32_bf16(xp[ks], __builtin_bit_cast(bf16x8, w), acc, 0, 0, 0); }
                      LAS float* dst = (q < 2) ? (Ps + (16 * nt + n) * 8 + 4 * q) : (yq + (16 * nt + n) * 8 + 4 * (q - 2));
                      *(LAS f32x4*)dst = acc; } }
                LDS_WAIT();
                __builtin_amdgcn_sched_barrier(0);
                float sa[8], y[8], vj[8];
                { const f32x4 p0 = *(const LAS f32x4*)(Ps + lane * 8), p1 = *(const LAS f32x4*)(Ps + lane * 8 + 4), q0 = *(const LAS f32x4*)(yq + lane * 8), q1 = *(const LAS f32x4*)(yq + lane * 8 + 4);
#pragma unroll
                  for (int e = 0; e < 4; ++e) { sa[e] = p0[e]; sa[4 + e] = p1[e]; y[e] = q0[e]; y[4 + e] = q1[e]; }
#pragma unroll
                  for (int j = 0; j < 8; ++j) vj[j] = vb[j * 64 + lane]; }
#pragma unroll
                for (int s = 1; s < 8; ++s) { float g[16];
                    __builtin_amdgcn_sched_barrier(0);
#pragma unroll
                    for (int t = 0; t < 4; ++t) if ((t & 1) * 4 < s) { const f32x4 gv = *(const LAS f32x4*)(GT + s * 16 + 4 * t); g[4 * t] = gv[0]; g[4 * t + 1] = gv[1]; g[4 * t + 2] = gv[2]; g[4 * t + 3] = gv[3]; }
                    float acc = sa[s];
#pragma unroll
                    for (int j = 0; j < s; ++j) { fmac_s(acc, sa[j], g[j]); fmac_s(acc, vj[j], g[8 + j]); }
                    sa[s] = acc; }
#pragma unroll
                for (int s = 0; s < 8; ++s) { float g[16];
                    __builtin_amdgcn_sched_barrier(0);
#pragma unroll
                    for (int t = 0; t < 4; ++t) if ((t & 1) * 4 <= s) { const f32x4 gv = *(const LAS f32x4*)(GT + (8 + s) * 16 + 4 * t); g[4 * t] = gv[0]; g[4 * t + 1] = gv[1]; g[4 * t + 2] = gv[2]; g[4 * t + 3] = gv[3]; }
                    float acc = y[s];
#pragma unroll
                    for (int j = 0; j <= s; ++j) { fmac_s(acc, sa[j], g[j]); fmac_s(acc, vj[j], g[8 + j]); }
                    y[s] = acc; }
                *(LAS f32x4*)(yq + lane * 8) = (f32x4){y[0], y[1], y[2], y[3]}; *(LAS f32x4*)(yq + lane * 8 + 4) = (f32x4){y[4], y[5], y[6], y[7]};
                *(LAS u32x4*)(UV + lane * 16) = pack8(sa); *(LAS u32x4*)(UV + lane * 16 + 8) = pack8(vj);
                LDS_WAIT();
                __builtin_amdgcn_sched_barrier(0);
                { bf16x8 tk[4], uv[4]; f32x4 gv[4];
                  const u32x4 z4 = (u32x4){0u, 0u, 0u, 0u};
#pragma unroll
                  for (int t = 0; t < 4; ++t) { gv[t] = *(const LAS f32x4*)(g7 + 16 * t + 4 * q);
                      const u32x4 a = *(const LAS u32x4*)(Tk + (16 * t + n) * 16 + 8 * (q & 1)), bq = *(const LAS u32x4*)(UV + (16 * t + n) * 16 + 8 * (q & 1));
                      tk[t] = __builtin_bit_cast(bf16x8, a); uv[t] = __builtin_bit_cast(bf16x8, q < 2 ? bq : z4); }
#pragma unroll
                  for (int mt = 0; mt < 4; ++mt)
#pragma unroll
                      for (int nt = 0; nt < 4; ++nt) { __builtin_amdgcn_sched_barrier(0); Sacc[mt][nt] = __builtin_amdgcn_mfma_f32_16x16x32_bf16(tk[mt], uv[nt], Sacc[mt][nt] * gv[mt], 0, 0, 0); } }
                __builtin_amdgcn_sched_barrier(0);
            }
            __builtin_amdgcn_sched_barrier(0);
            { const int cn2 = c + 2 < 256 ? c + 2 : 255; WF_LOAD(w1); LORA_LOAD(sf1, cn2, 1); }
        }
    } else {
        { const float* mup = p.in[I_MUP]; const float* mun = p.in[I_MUN]; const int hc = h * 64 + lane;
#pragma unroll
          for (int X = 0; X < 3; ++X) { const float a_ = mup[X * BR + hc], b_ = mun[X * BR + hc]; cst[X * 64 + lane] = 1.f - a_ - b_; cst[(3 + X) * 64 + lane] = a_; cst[(6 + X) * 64 + lane] = b_; }
          cst[9 * 64 + lane] = p.in[I_KK][hc]; cst[10 * 64 + lane] = p.in[I_KA][hc]; cst[11 * 64 + lane] = p.in[I_RK][hc];
          cst[12 * 64 + lane] = p.in[I_LNW][hc]; cst[13 * 64 + lane] = p.in[I_LNB][hc];
          cst[14 * 64 + lane] = p.in[I_W0][dir * BR + hc]; cst[15 * 64 + lane] = p.in[I_A0][dir * BR + hc]; }
        LDS_WAIT();
        const int i = lane >> 3, j = lane & 7;
        bf16x8 wf[3][4]; WF_LOAD(wf);
        const char* Zc = (const char*)((const bf16_t*)(p.ws + WS_Z) + (size_t)b * TSEQ * NRKV + h * 64);
        bf16_t* EX = (bf16_t*)p.out + (size_t)b * TSEQ * BR + h * 64 + 8 * j;
        float* BS = (float*)(p.ws + WS_BSC) + (size_t)b * TSEQ * 64 + h;
        const int src2 = 8 * ((i & ~3) + 1) + j, src3 = 24 + j;
        u32x4 x0[3], xm[3], xp[3]; u32x4 exn = (u32x4){0u, 0u, 0u, 0u}; float bon_n = 0.f;
#define ISSUE_Z(cn) do { const int _t = dir ? (2047 - 8 * (cn) - i) : (8 * (cn) + i); const unsigned _o = ((unsigned)_t * NRKV + 8u * (unsigned)j) * 2u; \
            const unsigned _om = _t > 0 ? _o - 2u * NRKV : _o, _op = _t < TSEQ - 1 ? _o + 2u * NRKV : _o; \
            _Pragma("unroll") for (int X = 0; X < 3; ++X) { const char* _zx = Zc + (size_t)X * (BR * 2); x0[X] = *(const u32x4*)(_zx + _o); xm[X] = *(const u32x4*)(_zx + _om); xp[X] = *(const u32x4*)(_zx + _op); } } while (0)
#define ISSUE_EX(ccn) do { const int _t = dir ? (2047 - 8 * (ccn) - i) : (8 * (ccn) + i); exn = *(const u32x4*)(EX + (size_t)_t * BR); bon_n = BS[(size_t)_t * 64]; } while (0)
#define LDC(dst, k) do { const f32x4 _a = *(const LAS f32x4*)(cst + (k) * 64 + 8 * j), _b = *(const LAS f32x4*)(cst + (k) * 64 + 8 * j + 4); dst[0] = (f32x2){_a[0], _a[1]}; dst[1] = (f32x2){_a[2], _a[3]}; dst[2] = (f32x2){_b[0], _b[1]}; dst[3] = (f32x2){_b[2], _b[3]}; } while (0)
#define LD8(dst, ptr) do { const f32x4 _a = *(const LAS f32x4*)(ptr), _b = *(const LAS f32x4*)((ptr) + 4); dst[0] = (f32x2){_a[0], _a[1]}; dst[1] = (f32x2){_a[2], _a[3]}; dst[2] = (f32x2){_b[0], _b[1]}; dst[3] = (f32x2){_b[2], _b[3]}; } while (0)
#define PK8(v) ((u32x4){pk2(v[0].x, v[0].y), pk2(v[1].x, v[1].y), pk2(v[2].x, v[2].y), pk2(v[3].x, v[3].y)})
        bf16x8 sf0[3];
        ISSUE_Z(0); LORA_LOAD(sf0, 0, 0);
        for (int c = 0; c < 258; ++c) {
            PAIR_SYNC(c);
            if (c == 130) { while (pgo[1] < 131u) __builtin_amdgcn_s_sleep(1); asm volatile("" ::: "memory"); ISSUE_EX(128); }
            f32x2 rr[4], kp[4], vp[4];
            if (c < 256) {
                const int t = dir ? (2047 - 8 * c - i) : (8 * c + i);
                const bool hm = t > 0, hp = t < TSEQ - 1;
#pragma unroll
                for (int X = 0; X < 3; ++X) { f32x2 c0[4], cp[4], cn[4]; __builtin_amdgcn_sched_barrier(0); LDC(c0, X); LDC(cp, 3 + X); LDC(cn, 6 + X);
                    u32x4 wm = xm[X], wp = xp[X]; const u32x4 w0 = x0[X];
                    if (c == 0 || c == 255) { wm = hm ? wm : (u32x4){0u, 0u, 0u, 0u}; wp = hp ? wp : (u32x4){0u, 0u, 0u, 0u}; }
#pragma unroll
                    for (int qq = 0; qq < 4; ++qq) { const f32x2 z0 = (f32x2){bflo(w0[qq]), bfhi(w0[qq])}, zm = (f32x2){bflo(wm[qq]), bfhi(wm[qq])}, zp = (f32x2){bflo(wp[qq]), bfhi(wp[qq])};
                        const f32x2 z = zp * cn[qq] + (zm * cp[qq] + z0 * c0[qq]);
                        if (X == 0) rr[qq] = z; else if (X == 1) kp[qq] = z; else vp[qq] = z; } }
            }
            __builtin_amdgcn_sched_barrier(0);
            if (c >= 2) {
                const int cc = c - 2; const int t = dir ? (2047 - 8 * cc - i) : (8 * cc + i);
                const bool second = cc >= 128;
                const LAS float* yo = yb + (cc & 1) * 512 + (8 * j) * 8 + i;
                float y[8];
#pragma unroll
                for (int e = 0; e < 8; ++e) y[e] = yo[e * 8];
                const float bmine = bon[(cc & 1) * 8 + i];
                if (!second) { *(u32x4*)(EX + (size_t)t * BR) = pack8(y); if (j == 0) BS[(size_t)t * 64] = bmine; }
                else {
                    float e8[8]; unpack8(exn, e8); float s = 0.f;
#pragma unroll
                    for (int e = 0; e < 8; ++e) { y[e] += e8[e]; s += y[e]; }
                    const float mean = oct_sum(s) * (1.f / 64.f); float qq = 0.f;
#pragma unroll
                    for (int e = 0; e < 8; ++e) { y[e] -= mean; qq += y[e] * y[e]; }
                    const float rstd = __builtin_amdgcn_rsqf(oct_sum(qq) * (1.f / 64.f) + 64e-5f);
                    const LAS float* vin = (const LAS float*)(base + (cc & 1) * SI_SZ + SI_V) + i * 64 + 8 * j;
                    const f32x4 va = *(const LAS f32x4*)vin, vb2 = *(const LAS f32x4*)(vin + 4);
                    const f32x4 lwa = *(const LAS f32x4*)(cst + 12 * 64 + 8 * j), lwb = *(const LAS f32x4*)(cst + 12 * 64 + 8 * j + 4);
                    const f32x4 lba = *(const LAS f32x4*)(cst + 13 * 64 + 8 * j), lbb = *(const LAS f32x4*)(cst + 13 * 64 + 8 * j + 4);
                    const float bsum = bmine + bon_n; float o[8];
#pragma unroll
                    for (int e = 0; e < 4; ++e) { o[e] = y[e] * rstd * lwa[e] + lba[e] + bsum * va[e]; o[4 + e] = y[4 + e] * rstd * lwb[e] + lbb[e] + bsum * vb2[e]; }
                    *(u32x4*)(EX + (size_t)t * BR) = pack8(o);
                }
            }
            __builtin_amdgcn_sched_barrier(0);
            if (c < 256) {
                LORA_MMA(wf, sf0, lsc0);
                LDS_WAIT();
                LAS unsigned char* ob = base + (c & 1) * SI_SZ;
                LAS bf16_t* Xs = (LAS bf16_t*)(ob + SI_X); LAS bf16_t* Hs = (LAS bf16_t*)(ob + SI_H); LAS bf16_t* Tk = (LAS bf16_t*)(ob + SI_T);
                LAS float* vb = (LAS float*)(ob + SI_V); LAS float* g7 = (LAS float*)(ob + SI_G7);
                *(LAS f32x4*)(vb + i * 64 + 8 * j) = (f32x4){vp[0].x, vp[0].y, vp[1].x, vp[1].y}; *(LAS f32x4*)(vb + i * 64 + 8 * j + 4) = (f32x4){vp[2].x, vp[2].y, vp[3].x, vp[3].y};
                f32x2 cv[4], kk[4], ss2 = (f32x2){0.f, 0.f};
                LDC(cv, 9);
#pragma unroll
                for (int qq = 0; qq < 4; ++qq) { kk[qq] = kp[qq] * cv[qq]; ss2 = kk[qq] * kk[qq] + ss2; }
                const float inv = 1.f / fmaxf(sqrtf(oct_sum(ss2.x + ss2.y)), 1e-12f);
                __builtin_amdgcn_sched_barrier(0);
                f32x2 ad[4], kd[4];
                { f32x2 la2[4]; LD8(la2, lsc1 + (c & 1) * 512 + i * 64 + 8 * j); LDC(cv, 15);
#pragma unroll
                  for (int qq = 0; qq < 4; ++qq) { const f32x2 al = cv[qq] + la2[qq]; ad[qq] = (f32x2){sigmoidf_(al.x), sigmoidf_(al.y)}; kk[qq] = kk[qq] * inv; } }
                LDC(cv, 10);
#pragma unroll
                for (int qq = 0; qq < 4; ++qq) kd[qq] = kp[qq] * ((ad[qq] - 1.f) * cv[qq] + 1.f);
                LDC(cv, 11);
                { f32x2 bo2 = (f32x2){0.f, 0.f};
#pragma unroll
                  for (int qq = 0; qq < 4; ++qq) bo2 = (rr[qq] * kd[qq]) * cv[qq] + bo2;
                  const float bo = oct_sum(bo2.x + bo2.y);
                  if (j == 0) bon[(c & 1) * 8 + i] = bo; }
                __builtin_amdgcn_sched_barrier(0);
                f32x2 dec[4], inc[4];
                { f32x2 lw2[4]; LD8(lw2, lsc0 + i * 64 + 8 * j); LDC(cv, 14);
#pragma unroll
                  for (int qq = 0; qq < 4; ++qq) { const f32x2 wl = cv[qq] + lw2[qq];
                      dec[qq] = (f32x2){fexp(-0.6065306597126334f * sigmoidf_(wl.x)), fexp(-0.6065306597126334f * sigmoidf_(wl.y))}; } }
#pragma unroll
                for (int qq = 0; qq < 4; ++qq) { float xs[2] = {dec[qq].x, dec[qq].y};
#pragma unroll
                    for (int hh = 0; hh < 2; ++hh) { float x = xs[hh];
                        x *= __builtin_bit_cast(float, __builtin_amdgcn_update_dpp(0x3f800000, __builtin_bit_cast(int, x), 0x118, 0xf, 0xf, false));
                        const float t2 = __shfl(x, src2); x = (i & 2) ? x * t2 : x;
                        const float t3 = __shfl(x, src3); x = (i & 4) ? x * t3 : x;
                        xs[hh] = x; }
                    inc[qq] = (f32x2){xs[0], xs[1]}; }
                if (i == 7) { *(LAS f32x4*)(g7 + 8 * j) = (f32x4){inc[0].x, inc[0].y, inc[1].x, inc[1].y}; *(LAS f32x4*)(g7 + 8 * j + 4) = (f32x4){inc[2].x, inc[2].y, inc[3].x, inc[3].y}; }
                f32x2 bhv[4], khv[4];
                { f32x2 at[4], rt[4];
#pragma unroll
                  for (int qq = 0; qq < 4; ++qq) { const f32x2 ig = (f32x2){frcp(inc[qq].x), frcp(inc[qq].y)}, ex = inc[qq] * (f32x2){frcp(dec[qq].x), frcp(dec[qq].y)};
                      at[qq] = -(kk[qq] * ex); rt[qq] = rr[qq] * inc[qq]; bhv[qq] = (kk[qq] * ad[qq]) * ig; khv[qq] = kd[qq] * ig; }
                  *(LAS u32x4*)(Xs + i * XS + 8 * j) = PK8(at); *(LAS u32x4*)(Xs + (8 + i) * XS + 8 * j) = PK8(rt);
                  *(LAS u32x4*)(Hs + i * XS + 8 * j) = PK8(bhv); *(LAS u32x4*)(Hs + (8 + i) * XS + 8 * j) = PK8(khv); }
                LDS_WAIT();
                { f32x2 gg[4]; LD8(gg, g7 + 8 * j);
#pragma unroll
                  for (int qq = 0; qq < 4; ++qq) { const f32x2 bc = bhv[qq] * gg[qq], kc = khv[qq] * gg[qq];
                      const unsigned wb = pk2(bc.x, bc.y), wk = pk2(kc.x, kc.y);
                      Tk[(8 * j + 2 * qq) * 16 + i] = (bf16_t)wb; Tk[(8 * j + 2 * qq + 1) * 16 + i] = (bf16_t)(wb >> 16);
                      Tk[(8 * j + 2 * qq) * 16 + 8 + i] = (bf16_t)wk; Tk[(8 * j + 2 * qq + 1) * 16 + 8 + i] = (bf16_t)(wk >> 16); } }
            }
            asm volatile("s_waitcnt vmcnt(0)" ::: "memory");
            __builtin_amdgcn_sched_barrier(0);
            { const int cn1 = c + 1 < 256 ? c + 1 : 255; ISSUE_Z(cn1); LORA_LOAD(sf0, cn1, 0); }
            if (c >= 130) { const int ccn = c - 1 < 255 ? c - 1 : 255; while (pgo[1] < (unsigned)(259 - ccn)) __builtin_amdgcn_s_sleep(1); asm volatile("" ::: "memory"); ISSUE_EX(ccn); }
        }
#undef ISSUE_Z
#undef ISSUE_EX
#undef LDC
#undef LD8
#undef PK8
    }
#undef PAIR_SYNC
#undef LORA_LOAD
#undef LORA_MMA
#undef WF_LOAD
    __builtin_amdgcn_s_setprio(0);
    __syncthreads();
}

__device__ __forceinline__ void sgu_phase(LAS unsigned char* lds, const Params& p, const int wv) {
    const int tid = fresh_tid(wv), lane = tid & 63, wave = __builtin_amdgcn_readfirstlane(tid >> 6), kq = lane >> 4, l15 = lane & 15;
    LAS bf16_t* vn = (LAS bf16_t*)lds;
    LAS bf16_t* wsl = (LAS bf16_t*)(lds + 69632);
    constexpr int VS = 264, WSS = 136;
    const bf16_t* V = (const bf16_t*)(p.ws + WS_V); bf16_t* UG = (bf16_t*)(p.ws + WS_UG); const bf16_t* wsb = (const bf16_t*)(p.ws + WS_WS);
    const float* lnsum = (const float*)(p.ws + WS_STATS) + MTOK; const float* lnsq = lnsum + MTOK;
    int cur_g = -1;
    for (int job = blockIdx.x; job < 2048; job += gridDim.x) {
        const int g = job & 15, tok0 = (job >> 4) * 128;
        if (g != cur_g) {
            cur_g = g;
#pragma unroll
            for (int k = 0; k < 4; ++k) { const int qi = tid + 512 * k, row = qi >> 4, c16 = qi & 15;
                *(LAS u32x4*)(wsl + row * WSS + c16 * 8) = *(const u32x4*)(wsb + (size_t)(g * 128 + row) * 128 + c16 * 8); }
        }
        {   const int cc = tid & 31, r0 = tid >> 5, ch = g * 256 + cc * 8;
            const f32x4 ga = *(const f32x4*)(p.in[I_GLNG] + ch), gb = *(const f32x4*)(p.in[I_GLNG] + ch + 4), ba = *(const f32x4*)(p.in[I_GLNB] + ch), bb = *(const f32x4*)(p.in[I_GLNB] + ch + 4);
#pragma unroll
            for (int q = 0; q < 8; ++q) { const int r = r0 + 16 * q, row = tok0 + r;
                const float mean = lnsum[row] * (1.f / BR), var = lnsq[row] * (1.f / BR) - mean * mean, rstd = __builtin_amdgcn_rsqf(fmaxf(var, 0.f) + 1e-5f);
                const u32x4 w = *(const u32x4*)(V + (size_t)row * BR + ch); float x[8]; unpack8(w, x);
#pragma unroll
                for (int e = 0; e < 4; ++e) { x[e] = (x[e] - mean) * rstd * ga[e] + ba[e]; x[4 + e] = (x[4 + e] - mean) * rstd * gb[e] + bb[e]; }
                *(LAS u32x4*)(vn + r * VS + cc * 8) = pack8(x); } }
        u32x2 ugv[8][2];
#pragma unroll
        for (int it = 0; it < 8; ++it)
#pragma unroll
            for (int dt = 0; dt < 2; ++dt) ugv[it][dt] = *(const u32x2*)(UG + (size_t)(tok0 + 16 * it + l15) * BR + g * 256 + 32 * wave + 16 * dt + 4 * kq);
        __syncthreads();
        f32x4 acc[2][8];
#pragma unroll
        for (int dt = 0; dt < 2; ++dt)
#pragma unroll
            for (int it = 0; it < 8; ++it) acc[dt][it] = (f32x4){0.f, 0.f, 0.f, 0.f};
#pragma unroll 1
        for (int ks = 0; ks < 4; ++ks) {
            bf16x8 xf[2];
#pragma unroll
            for (int dt = 0; dt < 2; ++dt)
#pragma unroll
                for (int e = 0; e < 8; ++e) xf[dt][e] = (short)vn[(32 * ks + 8 * kq + e) * VS + 32 * wave + 16 * dt + l15];
#pragma unroll
            for (int it = 0; it < 8; ++it) { const bf16x8 yf = *(const LAS bf16x8*)(wsl + (16 * it + l15) * WSS + 32 * ks + 8 * kq);
#pragma unroll
                for (int dt = 0; dt < 2; ++dt) acc[dt][it] = __builtin_amdgcn_mfma_f32_16x16x32_bf16(xf[dt], yf, acc[dt][it], 0, 0, 0); }
        }
#pragma unroll
        for (int it = 0; it < 8; ++it) { const int ti = 16 * it + l15; const float bs = p.in[I_GBS][g * 128 + ti];
#pragma unroll
            for (int dt = 0; dt < 2; ++dt) { bf16_t* up = UG + (size_t)(tok0 + ti) * BR + g * 256 + 32 * wave + 16 * dt + 4 * kq;
                const u32x2 uw = ugv[it][dt];
                u32x2 o; o.x = pk2(bflo(uw.x) * (acc[dt][it][0] + bs), bfhi(uw.x) * (acc[dt][it][1] + bs)); o.y = pk2(bflo(uw.y) * (acc[dt][it][2] + bs), bfhi(uw.y) * (acc[dt][it][3] + bs));
                *(u32x2*)up = o; } }
        __syncthreads();
    }
}

#define XB_TMO      128
#define XB_XCNT(j)  (256  + 64 * (j))
#define XB_XSUB(j)  (1280 + 64 * (j))
#define XB_XGEN(j)  (2304 + 64 * (j))
#define XB_TOP      3328
#define XB_TOPGEN   3392
#define XCD_BAR_WORDS 3456
#define XB_SPIN_CAP (1u << 18)

__device__ __forceinline__ unsigned xb_ld(unsigned* p)              { return __hip_atomic_load(p, __ATOMIC_RELAXED, __HIP_MEMORY_SCOPE_AGENT); }
__device__ __forceinline__ unsigned xb_add(unsigned* p, unsigned v) { return __hip_atomic_fetch_add(p, v, __ATOMIC_RELAXED, __HIP_MEMORY_SCOPE_AGENT); }
__device__ __forceinline__ unsigned xb_xcc_id() { return (unsigned)__builtin_amdgcn_s_getreg((3 << 11) | 20) & 0xFu; }
#define XB_SPIN(cond, bar) do { unsigned _sp = 0; while (cond) { __builtin_amdgcn_s_sleep(1); \
    if ((++_sp & 255u) == 0u) { if (xb_ld(&(bar)[XB_TMO])) break; if (_sp > XB_SPIN_CAP) { atomicAdd(&(bar)[XB_TMO], 1u); break; } } } } while (0)

struct XcdBarrier {
    unsigned* bar; unsigned x;
    volatile LAS unsigned* st;
};

__device__ __forceinline__ XcdBarrier xcd_barrier_post(unsigned* bar, volatile LAS unsigned* st, int wv) {
    XcdBarrier b; b.bar = bar; b.x = xb_xcc_id(); b.st = st;
    if (wv == 0 && __builtin_amdgcn_mbcnt_hi(~0u, __builtin_amdgcn_mbcnt_lo(~0u, 0u)) == 0u) (void)xb_add(&bar[XB_XCNT(b.x)], 1u);
    return b;
}
__device__ __forceinline__ void xcd_barrier_complete(unsigned* bar, unsigned x, unsigned& nloc, unsigned& nx) {
    const unsigned G = gridDim.x * gridDim.y * gridDim.z;
    unsigned sum, cnt, mine, sp = 0u;
    for (;;) {
        sum = 0u; cnt = 0u; mine = 0u;
#pragma unroll
        for (unsigned j = 0; j < 16; ++j) { const unsigned c = xb_ld(&bar[XB_XCNT(j)]); sum += c; cnt += (c > 0u) ? 1u : 0u; mine = (j == x) ? c : mine; }
        if (sum == G) break;
        __builtin_amdgcn_s_sleep(1);
        if ((++sp & 255u) == 0u) { if (xb_ld(&bar[XB_TMO])) break; if (sp > XB_SPIN_CAP) { atomicAdd(&bar[XB_TMO], 1u); break; } }
    }
    nloc = mine > 0u ? mine : 1u; nx = cnt > 0u ? cnt : 1u;
}

__device__ __forceinline__ void xcd_barrier(const XcdBarrier& b, int wv) {
    asm volatile("s_waitcnt vmcnt(0)" ::: "memory");
    __syncthreads();
    if (wv == 0 && __builtin_amdgcn_mbcnt_hi(~0u, __builtin_amdgcn_mbcnt_lo(~0u, 0u)) == 0u) {
        unsigned* bar = b.bar;
        __builtin_amdgcn_s_waitcnt(0);
        unsigned nloc = b.st[0], nx = b.st[1];
        if (nloc == 0u) { xcd_barrier_complete(bar, b.x, nloc, nx); b.st[0] = nloc; b.st[1] = nx; }
        const unsigned old = xb_add(&bar[XB_XSUB(b.x)], 1u);
        const unsigned gen = old / nloc;
        if (old + 1u == (gen + 1u) * nloc) {
            __builtin_amdgcn_fence(__ATOMIC_RELEASE, "agent");
            asm volatile("s_waitcnt vmcnt(0)" ::: "memory");
            const unsigned og = xb_add(&bar[XB_TOP], 1u);
            const unsigned tg = og / nx;
            if (og + 1u == (tg + 1u) * nx) xb_add(&bar[XB_TOPGEN], 1u);
            else XB_SPIN(xb_ld(&bar[XB_TOPGEN]) == tg, bar);
            __builtin_amdgcn_fence(__ATOMIC_ACQUIRE, "agent");
            xb_add(&bar[XB_XGEN(b.x)], 1u);
            asm volatile("s_waitcnt vmcnt(0)" ::: "memory");
        } else {
            XB_SPIN(xb_ld(&bar[XB_XGEN(b.x)]) == gen, bar);
            __builtin_amdgcn_fence(__ATOMIC_ACQUIRE, "agent");
            asm volatile("s_waitcnt vmcnt(0)" ::: "memory");
        }
    }
    __syncthreads();
}

__device__ __forceinline__ void grid_bar(unsigned* ctr, unsigned target, int wv) {
    __syncthreads();
    if (wv == 0) {
        __builtin_amdgcn_fence(__ATOMIC_RELEASE, "agent");
        if (__builtin_amdgcn_mbcnt_hi(~0u, __builtin_amdgcn_mbcnt_lo(~0u, 0u)) == 0u) {
            __hip_atomic_fetch_add(ctr, 1u, __ATOMIC_RELAXED, __HIP_MEMORY_SCOPE_AGENT);
            while (__hip_atomic_load(ctr, __ATOMIC_RELAXED, __HIP_MEMORY_SCOPE_AGENT) < target) __builtin_amdgcn_s_sleep(1);
        }
        __builtin_amdgcn_fence(__ATOMIC_ACQUIRE, "agent");
    }
    __syncthreads();
}
__global__ void __launch_bounds__(NTHREADS, 2) fwd_kernel(Params p) {
    __builtin_assume(__builtin_amdgcn_workitem_id_y() == 0); __builtin_assume(__builtin_amdgcn_workitem_id_z() == 0);
    extern __shared__ __attribute__((aligned(16))) unsigned char lds_raw[];
    LAS unsigned char* lds = (LAS unsigned char*)lds_raw;
    cg::grid_group grid = cg::this_grid();
    const int wv = __builtin_amdgcn_readfirstlane((int)threadIdx.x >> 6);
    const int G = gridDim.x, NGW = G * NWAVES;
    const size_t NGT = (size_t)G * NTHREADS;
    unsigned char* ws = p.ws;
    float* rstd0 = (float*)(ws + WS_RSTD0); float* stats = (float*)(ws + WS_STATS);
#define PHASE_IDS() const int tid = fresh_tid(wv), lane = tid & 63, wave = __builtin_amdgcn_readfirstlane(tid >> 6); const int gw = blockIdx.x * NWAVES + wave; \
    const size_t gtid = (size_t)blockIdx.x * NTHREADS + tid; LAS float* scr = (LAS float*)(lds + wave * 16384); (void)lane; (void)gw; (void)gtid; (void)scr
    const int lo = p.ph_lo, hi = p.ph_hi;
#define IN(k) (lo <= (k) && (k) < hi)
    unsigned* barctr = (unsigned*)(ws + WS_MISC + 400 * 1024);
    volatile LAS unsigned* xst = (volatile LAS unsigned*)(lds + 149760 + 64);
    if (wv == 0 && __builtin_amdgcn_mbcnt_hi(~0u, __builtin_amdgcn_mbcnt_lo(~0u, 0u)) == 0u) { xst[0] = 0u; xst[1] = 0u; }
    XcdBarrier xb; xb.bar = barctr; xb.x = 0u; xb.st = xst;
#define SEAM(k) do { if (IN(k) && IN((k) + 1)) { if ((k) == 0) { grid.sync(); xb = xcd_barrier_post(barctr, xst, wv); } else xcd_barrier(xb, wv); } } while (0)

    if (IN(0)) {
        PHASE_IDS();
        for (size_t k = gtid; k < 4 * MTOK; k += NGT) stats[k] = 0.f;
        for (size_t k = gtid; k < XCD_BAR_WORDS; k += NGT) barctr[k] = 0u;
        for (int m = gw; m < MTOK; m += NGW) {
            const f32x4* xr = (const f32x4*)(p.in[I_X] + (size_t)m * DM) + lane; f32x4 v[8]; float s = 0.f;
#pragma unroll
            for (int jj = 0; jj < 8; ++jj) { v[jj] = xr[64 * jj]; s += (v[jj][0] * v[jj][0] + v[jj][1] * v[jj][1]) + (v[jj][2] * v[jj][2] + v[jj][3] * v[jj][3]); }
            s = wave_sum(s);
            const float rs0 = 1.f / sqrtf(s * (1.f / DM) + 1e-5f);
            u32x2* o8 = (u32x2*)((bf16_t*)(ws + WS_A0) + (size_t)m * DM) + lane;
#pragma unroll
            for (int jj = 0; jj < 8; ++jj) { u32x2 o; o.x = pk2(v[jj][0] * rs0, v[jj][1] * rs0); o.y = pk2(v[jj][2] * rs0, v[jj][3] * rs0); o8[64 * jj] = o; }
        }
        convert_matrix(p.in[I_RWIN], RIN, DM, N1PAD, (bf16_t*)(ws + WS_WRKV), p.in[I_NG], scr, gw, NGW, lane, [](int n0) { return n0 < SHIFTC ? n0 : -1; });
        {
            u32x4* dst = (u32x4*)(ws + WS_LORA);
            for (size_t it = gtid; it < (size_t)2 * 2 * 64 * 3 * 4 * 64; it += NGT) {
                const int l = (int)(it & 63), nt = (int)((it >> 6) & 3), ks = (int)((it >> 8) % 3), hh = (int)((it / 768) & 63), d = (int)((it / 49152) & 1), mat = (int)(it / 98304);
                const float* up = (mat ? p.in[I_AUP] : p.in[I_WUP]) + (size_t)d * 96 * BR + (size_t)(32 * ks + 8 * (l >> 4)) * BR + 64 * hh + 16 * nt + (l & 15);
                float v[8];
#pragma unroll
                for (int e = 0; e < 8; ++e) v[e] = up[(size_t)e * BR];
                dst[it] = pack8(v); } }
        {   bf16_t* wsb = (bf16_t*)(ws + WS_WS);
            for (size_t k = gtid; k < (size_t)16 * 128 * 128 / 2; k += NGT) { const f32x2 v = *(const f32x2*)(p.in[I_GWS] + 2 * k); ((unsigned*)wsb)[k] = pk2(v.x, v.y); } }
    }
    SEAM(0);
    if (IN(1)) {
        pg8::Gemm g{(const bf16_t*)(ws + WS_A0), (const bf16_t*)(ws + WS_WRKV), MTOK, N1PAD, DM}; pg8::StaticOrder S; S.init(MTOK, N1PAD, G, (int)blockIdx.x);
        EpiZ E{(bf16_t*)(ws + WS_Z), (bf16_t*)(ws + WS_ZL), rstd0};
        pg8::gemm_phase<EpiZ, pg8::StaticOrder, true, true>(lds, g, S, E, wv);
    }
#if defined(REPEAT_PHASE) && REPEAT_PHASE == 1
    if (IN(1)) {
        pg8::Gemm g{(const bf16_t*)(ws + WS_A0), (const bf16_t*)(ws + WS_WRKV), MTOK, N1PAD, DM}; pg8::StaticOrder S; S.init(MTOK, N1PAD, G, (int)blockIdx.x);
        EpiZ E{(bf16_t*)(ws + WS_Z), (bf16_t*)(ws + WS_ZL), rstd0};
        pg8::gemm_phase<EpiZ, pg8::StaticOrder, true, true>(lds, g, S, E, wv);
    }
#endif
    SEAM(1);
    if (IN(2)) {
        PHASE_IDS();
        convert_matrix(p.in[I_RWIN], RIN, DM, BR, (bf16_t*)(ws + WS_WG), p.in[I_NG], scr, gw, NGW, lane, [](int n0) { return SHIFTC + n0; });
        convert_matrix(p.in[I_RWOUT], DM, BR, DM, (bf16_t*)(ws + WS_WO0), nullptr, scr, gw, NGW, lane, [](int n0) { return n0; });
        const bf16_t* ZL = (const bf16_t*)(ws + WS_ZL); bf16_t* ZLP = (bf16_t*)(ws + WS_ZLP);
        for (size_t it = gtid; it < (size_t)MTOK * 48; it += NGT) {
            const int row = (int)(it / 48), c0 = (int)(it % 48) * 8, t = row & (TSEQ - 1);
            const u32x4 z0 = *(const u32x4*)(ZL + (size_t)row * NLORA + c0);
            const u32x4 zm = t > 0 ? *(const u32x4*)(ZL + (size_t)(row - 1) * NLORA + c0) : (u32x4){0u, 0u, 0u, 0u};
            const u32x4 zp = t < TSEQ - 1 ? *(const u32x4*)(ZL + (size_t)(row + 1) * NLORA + c0) : (u32x4){0u, 0u, 0u, 0u};
            float a0[8], am[8], ap[8], o[8]; unpack8(z0, a0); unpack8(zm, am); unpack8(zp, ap);
#pragma unroll
            for (int e = 0; e < 8; ++e) { const float mp = p.in[I_MUP][NRKV + c0 + e], mn = p.in[I_MUN][NRKV + c0 + e];
                const float z = a0[e] + mp * (am[e] - a0[e]) + mn * (ap[e] - a0[e]); o[e] = c0 < 192 ? tanhf_(z) : z; }
            *(u32x4*)(ZLP + (size_t)row * NLORA + c0) = pack8(o);
        }
    }
    SEAM(2);
    if (IN(3)) { for (int pg = blockIdx.x; pg < 256; pg += G) scan_phase(lds, p, pg, wv); }
    SEAM(3);
    if (IN(4)) {
        PHASE_IDS();
        const float* g1 = p.in[I_NG] + DM;
        convert_matrix(p.in[I_GWIN], 3 * BR, DM, 3 * BR, (bf16_t*)(ws + WS_WIN1), g1, scr, gw, NGW, lane, [](int n0) {
            if (n0 >= 2 * BR) return BR + (n0 - 2 * BR);
            const int jj = n0 >> 8, half = (n0 >> 7) & 1, ii = n0 & 127; return (half ? 2 * BR : 0) + 128 * jj + ii; });
        convert_matrix(p.in[I_GWOUT], DM, BR, DM, (bf16_t*)(ws + WS_WO1), nullptr, scr, gw, NGW, lane, [](int n0) { return n0; });
        __syncthreads();
        pg8::Gemm g{(const bf16_t*)(ws + WS_A0), (const bf16_t*)(ws + WS_WG), MTOK, BR, DM}; pg8::StaticOrder S; S.init(MTOK, BR, G, (int)blockIdx.x);
        EpiGate E{(bf16_t*)p.out, rstd0};
        pg8::gemm_phase<EpiGate, pg8::StaticOrder, true, true>(lds, g, S, E, wv);
    }
    SEAM(4);
    if (IN(5)) {
        pg8::Gemm g{(const bf16_t*)p.out, (const bf16_t*)(ws + WS_WO0), MTOK, DM, BR}; pg8::StaticOrder S; S.init(MTOK, DM, G, (int)blockIdx.x);
        EpiH1 E{p.in[I_X], (bf16_t*)(ws + WS_A1), stats};
        pg8::gemm_phase<EpiH1, pg8::StaticOrder, true, true>(lds, g, S, E, wv);
    }
    SEAM(5);
    if (IN(6)) {
        pg8::Gemm g{(const bf16_t*)(ws + WS_A1), (const bf16_t*)(ws + WS_WIN1), MTOK, 3 * BR, DM}; pg8::StaticOrder S; S.init(MTOK, 3 * BR, G, (int)blockIdx.x);
        EpiL1 E{(bf16_t*)(ws + WS_UG), (bf16_t*)(ws + WS_V), stats, stats + MTOK, stats + 2 * MTOK};
        pg8::gemm_phase<EpiL1, pg8::StaticOrder, true, true>(lds, g, S, E, wv);
    }
    SEAM(6);
    if (IN(7)) sgu_phase(lds, p, wv);
    SEAM(7);
    if (IN(8)) {
        pg8::Gemm g{(const bf16_t*)(ws + WS_UG), (const bf16_t*)(ws + WS_WO1), MTOK, DM, BR}; pg8::StaticOrder S; S.init(MTOK, DM, G, (int)blockIdx.x);
        EpiH2 E{(const bf16_t*)(ws + WS_A1), (bf16_t*)(ws + WS_H1), stats + 3 * MTOK};
        pg8::gemm_phase<EpiH2, pg8::StaticOrder, true, true>(lds, g, S, E, wv);
    }
    SEAM(8);
    if (IN(9)) {
        PHASE_IDS();
        const float* ssq = stats + 3 * MTOK; const f32x4* gf = (const f32x4*)p.in[I_FNG] + lane;
        for (int m = gw; m < MTOK; m += 2 * NGW) {
            const int m2 = m + NGW < MTOK ? m + NGW : m;
            const float r = 1.f / sqrtf(ssq[m] * (1.f / DM) + 1e-5f), r2 = 1.f / sqrtf(ssq[m2] * (1.f / DM) + 1e-5f);
            const u32x2* hrow = (const u32x2*)((const bf16_t*)(ws + WS_H1) + (size_t)m * DM) + lane;
            const u32x2* hrow2 = (const u32x2*)((const bf16_t*)(ws + WS_H1) + (size_t)m2 * DM) + lane;
            u32x2 wa[8], wb[8];
#pragma unroll
            for (int jj = 0; jj < 8; ++jj) { wa[jj] = hrow[64 * jj]; wb[jj] = hrow2[64 * jj]; }
            f32x4* orow = (f32x4*)(p.out + (size_t)m * DM) + lane; f32x4* orow2 = (f32x4*)(p.out + (size_t)m2 * DM) + lane;
#pragma unroll
            for (int jj = 0; jj < 8; ++jj) { const f32x4 gv = gf[64 * jj];
                orow[64 * jj] = (f32x4){bflo(wa[jj].x), bfhi(wa[jj].x), bflo(wa[jj].y), bfhi(wa[jj].y)} * r * gv;
                if (m2 != m) orow2[64 * jj] = (f32x4){bflo(wb[jj].x), bfhi(wb[jj].x), bflo(wb[jj].y), bfhi(wb[jj].y)} * r2 * gv; }
        }
    }
}

extern "C" void kernel_launch(void* const* d_in, const int* in_sizes, int n_in, void* d_out, int out_size, void* d_ws, size_t ws_size, hipStream_t stream) {
    static int grid_blocks = 0;
    if (!grid_blocks) {
        int dev = 0, cus = 0, per_cu = 0;
        (void)hipGetDevice(&dev);
        (void)hipDeviceGetAttribute(&cus, hipDeviceAttributeMultiprocessorCount, dev);
        (void)hipFuncSetAttribute((const void*)fwd_kernel, hipFuncAttributeMaxDynamicSharedMemorySize, LDS_BYTES);
        (void)hipOccupancyMaxActiveBlocksPerMultiprocessor(&per_cu, (const void*)fwd_kernel, NTHREADS, LDS_BYTES);
        if (per_cu < 1) per_cu = 1;
        grid_blocks = cus * per_cu;
        if (ws_size < WS_END || n_in != 22) { fprintf(stderr, "kernel_launch: needs %zu bytes of workspace (got %zu), 22 inputs (got %d)\n", (size_t)WS_END, ws_size, n_in); grid_blocks = -1; }
    }
    if (grid_blocks < 0) return;
    Params p{};
    for (int i = 0; i < 22; ++i) p.in[i] = (const float*)d_in[i];
    p.out = (float*)d_out; p.ws = (unsigned char*)d_ws; p.ph_lo = 0; p.ph_hi = 10;
    void* args[] = {&p};
    hipError_t e = hipLaunchCooperativeKernel((void*)fwd_kernel, dim3(grid_blocks), dim3(NTHREADS), args, LDS_BYTES, stream);
    if (e != hipSuccess) fprintf(stderr, "cooperative launch failed: %s (grid %d)\n", hipGetErrorString(e), grid_blocks);
}
```

```cpp
#include <hip/hip_runtime.h>
#include <hip/hip_cooperative_groups.h>
#include <cstdio>
#include <cstdint>
namespace cg = cooperative_groups;

#define GAS __attribute__((address_space(1)))
#define LAS __attribute__((address_space(3)))
typedef unsigned short bf16_t;
typedef short bf16x8 __attribute__((ext_vector_type(8)));
typedef float f32x4 __attribute__((ext_vector_type(4)));
typedef float f32x2 __attribute__((ext_vector_type(2)));
typedef unsigned u32x4 __attribute__((ext_vector_type(4)));
typedef unsigned u32x2 __attribute__((ext_vector_type(2)));

constexpr int NTHREADS = 512, NWAVES = 8;
constexpr int LDS_BYTES = 150528;
constexpr int MTOK = 16384, DM = 2048, BR = 4096, TSEQ = 2048, NB = 8, NH = 64;
constexpr int RIN = 16768, SHIFTC = 12672, NRKV = 12288, NLORA = 384, N1PAD = 12800;
constexpr size_t MiB = 1ull << 20;
constexpr size_t WS_Z = 0;
constexpr size_t WS_ZL = 384 * MiB;
constexpr size_t WS_A0 = 396 * MiB;
constexpr size_t WS_WRKV = 460 * MiB;
constexpr size_t WS_ZLP = 460 * MiB;
constexpr size_t WS_WG = 472 * MiB;
constexpr size_t WS_WO0 = 488 * MiB;
constexpr size_t WS_H1 = 0;
constexpr size_t WS_A1 = 128 * MiB;
constexpr size_t WS_WIN1 = 192 * MiB;
constexpr size_t WS_WO1 = 240 * MiB;
constexpr size_t WS_UG = 256 * MiB;
constexpr size_t WS_V = 384 * MiB;
constexpr size_t WS_MISC = 512 * MiB;
constexpr size_t WS_RSTD0 = WS_MISC;
constexpr size_t WS_STATS = WS_MISC + 65536;
constexpr size_t WS_WS = WS_MISC + 512 * 1024;
constexpr size_t WS_LORA = WS_MISC + 1 * MiB;
constexpr size_t WS_BSC = WS_MISC + 4 * MiB;
constexpr size_t WS_END = WS_MISC + 8 * MiB;

__device__ __forceinline__ unsigned f2bf(float f) { unsigned u = __builtin_bit_cast(unsigned, f); return (u + 0x7fffu + ((u >> 16) & 1u)) >> 16; }
typedef __bf16 bf16x2_t __attribute__((ext_vector_type(2)));
__device__ __forceinline__ unsigned pk2(float lo, float hi) { f32x2 v = {lo, hi}; bf16x2_t b = __builtin_convertvector(v, bf16x2_t); return __builtin_bit_cast(unsigned, b); }
__device__ __forceinline__ float bflo(unsigned w) { return __builtin_bit_cast(float, w << 16); }
__device__ __forceinline__ float bfhi(unsigned w) { return __builtin_bit_cast(float, w & 0xffff0000u); }
__device__ __forceinline__ void unpack8(u32x4 w, float* o) { o[0] = bflo(w.x); o[1] = bfhi(w.x); o[2] = bflo(w.y); o[3] = bfhi(w.y); o[4] = bflo(w.z); o[5] = bfhi(w.z); o[6] = bflo(w.w); o[7] = bfhi(w.w); }
__device__ __forceinline__ u32x4 pack8(const float* v) { u32x4 w; w.x = pk2(v[0], v[1]); w.y = pk2(v[2], v[3]); w.z = pk2(v[4], v[5]); w.w = pk2(v[6], v[7]); return w; }
__device__ __forceinline__ float fexp(float x) { return __builtin_amdgcn_exp2f(x * 1.4426950408889634f); }
__device__ __forceinline__ float frcp(float x) { return __builtin_amdgcn_rcpf(x); }
__device__ __forceinline__ float sigmoidf_(float x) { return frcp(1.f + fexp(-x)); }
__device__ __forceinline__ float siluf_(float x) { return x * sigmoidf_(x); }
__device__ __forceinline__ float geluf_(float x) { const float u = 1.5957691216057308f * (x + 0.044715f * x * x * x); return x * sigmoidf_(u); }
__device__ __forceinline__ float tanhf_(float x) { return 1.f - 2.f * frcp(1.f + fexp(2.f * x)); }
__device__ __forceinline__ float wave_sum(float v) {
#pragma unroll
    for (int o = 1; o < 64; o <<= 1) v += __shfl_xor(v, o);
    return v;
}
template <int CTRL> __device__ __forceinline__ float dppf(float v) { return __builtin_bit_cast(float, __builtin_amdgcn_update_dpp(0, __builtin_bit_cast(int, v), CTRL, 0xf, 0xf, true)); }
__device__ __forceinline__ float quad_sum(float v) { v += dppf<0xB1>(v); v += dppf<0x4E>(v); return v; }
__device__ __forceinline__ float oct_sum(float v) { v = quad_sum(v); v += dppf<0x141>(v); return v; }

namespace pg8 {
#define PG8_LAS __attribute__((address_space(3)))
constexpr int BM = 256, BK = 64, HALF = 128, HTB = HALF * BK * 2, STAGE_BYTES = 8 * HTB, NXCD = 8, WGM = 8;
__host__ __device__ __forceinline__ int lds_byte(int r, int c) { const int st = (r >> 4) * 2 + (c >> 5), rr = r & 15, cc = c & 31, ob = rr * 64 + cc * 2; return st * 1024 + (ob ^ (((ob >> 9) & 1) << 5)); }
__host__ __device__ __forceinline__ void stage_rc(int b, int& R, int& C) { const int st = b / 1024, sb = b % 1024, swz = sb ^ (((sb >> 9) & 1) << 5); R = (st >> 1) * 16 + swz / 64; C = (st & 1) * 32 + (swz % 64) / 2; }
__host__ __device__ __forceinline__ int perm32(int rho) { const int n = rho >> 4, i = rho & 15; return 8 * (i >> 2) + 4 * n + (i & 3); }
struct Unit { int pm, pn; };
struct Gemm { const bf16_t* A; const bf16_t* Bt; int M, N, K; };
struct StaticOrder {
    int nM, nN, nwg, G, c;
    __host__ __device__ void init(int M, int N, int G_, int c_) { nM = M / BM; nN = N / BM; nwg = nM * nN; G = G_; c = c_; }
    __host__ __device__ bool next(int i, Unit& u) const {
        const long L = (long)i * G + c; if (L >= nwg) return false;
        int wgid = (int)L; { const int q = nwg / NXCD, r = nwg % NXCD, xcd = wgid % NXCD, off = wgid / NXCD; wgid = (xcd < r ? xcd * (q + 1) : r * (q + 1) + (xcd - r) * q) + off; }
        const int nig = WGM * nN, gid = wgid / nig, fm = gid * WGM, gsz = (nM - fm) < WGM ? (nM - fm) : WGM;
        u.pm = fm + ((wgid % nig) % gsz); u.pn = (wgid % nig) / gsz; return true;
    }
    __device__ __forceinline__ void a_ready(const Unit&) const {}
    __device__ __forceinline__ void done(const Unit&) const {}
};
template <class Epi, class Sched, bool ALIGN_EPI = false, bool SP2 = false>
__device__ __forceinline__ void gemm_phase(PG8_LAS unsigned char* lds, const Gemm g, const Sched& S, const Epi& E, const int wv) {
    const int wid = wv, lane = (int)__builtin_amdgcn_mbcnt_hi(~0u, __builtin_amdgcn_mbcnt_lo(~0u, 0u)), tid = wid * 64 + lane, wr = wid >> 2, wc = wid & 3, fr = lane & 15, fq = lane >> 4;
    const int K = g.K, nt = K / BK;
    unsigned voffA[2], voffB[2];
#pragma unroll
    for (int i = 0; i < 2; ++i) { int R, C; stage_rc(tid * 16 + i * 8192, R, C); const int Rb = Epi::PERM ? ((R & ~31) + perm32(R & 31)) : R;
        voffA[i] = (unsigned)(R * K + C) * 2u; voffB[i] = (unsigned)(Rb * K + C) * 2u; }
    const size_t kstep = (size_t)(BK * 2);
    const size_t hstep = (size_t)HALF * K * 2;
    const size_t tstep = 2 * hstep;
    const unsigned ldsw = (unsigned)wid * 1024u;
    const int aoff = lds_byte(wr * 64 + fr, fq * 8), boff = lds_byte(wc * 32 + fr, fq * 8);
#define PG8_SA(b, h) (((b) * 2 + (h)) * HTB)
#define PG8_SB(b, h) ((4 + (b) * 2 + (h)) * HTB)
#define PG8_STAGE(bufoff, gbase, voff) do { _Pragma("unroll") for (int _i = 0; _i < 2; ++_i) \
        __builtin_amdgcn_global_load_lds((const unsigned*)((const char*)(gbase) + (voff)[_i]), (PG8_LAS unsigned*)(lds + (bufoff) + ldsw + _i * 8192), 16, 0, 0); } while (0)
#define PG8_LDA(dst, b, h) do { _Pragma("unroll") for (int m = 0; m < 4; ++m) _Pragma("unroll") for (int k = 0; k < 2; ++k) dst[m][k] = *(const PG8_LAS bf16x8*)(lds + PG8_SA(b, h) + aoff + m * 2048 + k * 1024); } while (0)
#define PG8_LDB(dst, b, h) do { _Pragma("unroll") for (int n = 0; n < 2; ++n) _Pragma("unroll") for (int k = 0; k < 2; ++k) dst[n][k] = *(const PG8_LAS bf16x8*)(lds + PG8_SB(b, h) + boff + n * 2048 + k * 1024); } while (0)
#define PG8_MMA(ai, bj, At, Bt) do { __builtin_amdgcn_s_setprio(1); _Pragma("unroll") for (int m = 0; m < 4; ++m) _Pragma("unroll") for (int n = 0; n < 2; ++n) _Pragma("unroll") for (int k = 0; k < 2; ++k) \
        acc[ai][bj][m][n] = __builtin_amdgcn_mfma_f32_16x16x32_bf16(Bt[n][k], At[m][k], acc[ai][bj][m][n], 0, 0, 0); __builtin_amdgcn_s_setprio(0); } while (0)
#define PG8_WAIT_V(n) asm volatile("s_waitcnt vmcnt(" #n ")" ::: "memory")
#define PG8_WAIT_L(n) asm volatile("s_waitcnt lgkmcnt(" #n ")" ::: "memory")
#define PG8_BAR __builtin_amdgcn_s_barrier()
#define PG8_SCHED __builtin_amdgcn_sched_barrier(0)
    Unit cur, nxt; int ui = 0;
    if (!S.next(0, cur)) return;
    f32x4 acc[2][2][4][2];
#pragma unroll
    for (int a = 0; a < 2; ++a)
#pragma unroll
        for (int b = 0; b < 2; ++b)
#pragma unroll
            for (int m = 0; m < 4; ++m)
#pragma unroll
                for (int n = 0; n < 2; ++n) acc[a][b][m][n] = (f32x4){0.f, 0.f, 0.f, 0.f};
    bf16x8 At[4][2], B0[2][2], B1[2][2];
    const char* cA = (const char*)g.A + (size_t)cur.pm * tstep; const char* cB = (const char*)g.Bt + (size_t)cur.pn * tstep;
    S.a_ready(cur);
    if constexpr (SP2) {
        PG8_STAGE(PG8_SB(0, 0), cB, voffB); PG8_STAGE(PG8_SB(0, 1), cB + hstep, voffB); PG8_STAGE(PG8_SA(0, 0), cA, voffA); PG8_STAGE(PG8_SA(0, 1), cA + hstep, voffA);
        if (wr == 1) PG8_BAR;
        PG8_WAIT_V(2); PG8_BAR;
        PG8_STAGE(PG8_SB(1, 0), cB + kstep, voffB); PG8_STAGE(PG8_SA(1, 0), cA + kstep, voffA); PG8_STAGE(PG8_SB(1, 1), cB + hstep + kstep, voffB);
        PG8_WAIT_V(6); PG8_BAR;
    } else {
        PG8_STAGE(PG8_SB(0, 0), cB, voffB); PG8_STAGE(PG8_SA(0, 0), cA, voffA); PG8_STAGE(PG8_SB(0, 1), cB + hstep, voffB); PG8_STAGE(PG8_SA(0, 1), cA + hstep, voffA);
        if (wr == 1) PG8_BAR;
        PG8_WAIT_V(4); PG8_BAR;
        PG8_STAGE(PG8_SB(1, 0), cB + kstep, voffB); PG8_STAGE(PG8_SA(1, 0), cA + kstep, voffA); PG8_STAGE(PG8_SB(1, 1), cB + hstep + kstep, voffB);
        PG8_WAIT_V(6); PG8_BAR;
    }
    for (;;) {
        const bool has_next = S.next(ui + 1, nxt);
        const char* nA = has_next ? (const char*)g.A + (size_t)nxt.pm * tstep : cA; const char* nB = has_next ? (const char*)g.Bt + (size_t)nxt.pn * tstep : cB;
        for (int t = 0; t < nt; t += 2) {
            const bool last = (t == nt - 2);
            const char* a1 = cA + (size_t)(t + 1) * kstep;
            const char* a2 = last ? nA : cA + (size_t)(t + 2) * kstep; const char* b2 = last ? nB : cB + (size_t)(t + 2) * kstep;
            const char* a3 = a2 + kstep; const char* b3 = b2 + kstep;
            if (last && has_next) S.a_ready(nxt);
            if constexpr (SP2) {
            PG8_LDB(B0, 0, 0); PG8_LDB(B1, 0, 1); PG8_SCHED; PG8_LDA(At, 0, 0); PG8_STAGE(PG8_SA(1, 1), a1 + hstep, voffA);
            PG8_WAIT_V(8); PG8_WAIT_L(0); PG8_BAR; PG8_MMA(0, 0, At, B0); PG8_MMA(0, 1, At, B1); PG8_BAR; PG8_SCHED;
            PG8_LDA(At, 0, 1); PG8_STAGE(PG8_SB(0, 0), b2, voffB); PG8_STAGE(PG8_SB(0, 1), b2 + hstep, voffB); PG8_STAGE(PG8_SA(0, 0), a2, voffA);
            PG8_WAIT_V(8); PG8_WAIT_L(0); PG8_BAR; PG8_MMA(1, 0, At, B0); PG8_MMA(1, 1, At, B1); PG8_BAR; PG8_SCHED;
            PG8_LDB(B0, 1, 0); PG8_LDB(B1, 1, 1); PG8_SCHED; PG8_LDA(At, 1, 0); PG8_STAGE(PG8_SA(0, 1), a2 + hstep, voffA);
            PG8_WAIT_V(8); PG8_WAIT_L(0); PG8_BAR; PG8_MMA(0, 0, At, B0); PG8_MMA(0, 1, At, B1); PG8_BAR; PG8_SCHED;
            PG8_LDA(At, 1, 1); PG8_STAGE(PG8_SB(1, 0), b3, voffB); PG8_STAGE(PG8_SB(1, 1), b3 + hstep, voffB); PG8_STAGE(PG8_SA(1, 0), a3, voffA);
            PG8_WAIT_V(8); PG8_WAIT_L(0); PG8_BAR; PG8_MMA(1, 0, At, B0); PG8_MMA(1, 1, At, B1); PG8_BAR; PG8_SCHED;
            } else {
            PG8_LDB(B0, 0, 0); PG8_SCHED; PG8_LDA(At, 0, 0); PG8_STAGE(PG8_SA(1, 1), a1 + hstep, voffA);
            PG8_WAIT_L(8); PG8_BAR; PG8_WAIT_L(0); PG8_MMA(0, 0, At, B0); PG8_BAR; PG8_SCHED;
            PG8_LDB(B1, 0, 1); PG8_STAGE(PG8_SB(0, 0), b2, voffB);
            PG8_BAR; PG8_WAIT_L(0); PG8_MMA(0, 1, At, B1); PG8_BAR;
            PG8_LDA(At, 0, 1); PG8_STAGE(PG8_SA(0, 0), a2, voffA);
            PG8_BAR; PG8_WAIT_L(0); PG8_MMA(1, 0, At, B0); PG8_BAR; PG8_SCHED;
            PG8_STAGE(PG8_SB(0, 1), b2 + hstep, voffB);
            PG8_WAIT_V(6); PG8_BAR; PG8_MMA(1, 1, At, B1); PG8_BAR;
            PG8_LDB(B0, 1, 0); PG8_SCHED; PG8_LDA(At, 1, 0); PG8_STAGE(PG8_SA(0, 1), a2 + hstep, voffA);
            PG8_WAIT_L(8); PG8_BAR; PG8_WAIT_L(0); PG8_MMA(0, 0, At, B0); PG8_BAR; PG8_SCHED;
            PG8_LDB(B1, 1, 1); PG8_STAGE(PG8_SB(1, 0), b3, voffB);
            PG8_BAR; PG8_WAIT_L(0); PG8_MMA(0, 1, At, B1); PG8_BAR;
            PG8_LDA(At, 1, 1); PG8_STAGE(PG8_SA(1, 0), a3, voffA);
            PG8_BAR; PG8_WAIT_L(0); PG8_MMA(1, 0, At, B0); PG8_BAR; PG8_SCHED;
            PG8_STAGE(PG8_SB(1, 1), b3 + hstep, voffB);
            PG8_WAIT_V(6); PG8_BAR; PG8_MMA(1, 1, At, B1); PG8_BAR;
            }
        }
        if constexpr (ALIGN_EPI) { if (wr == 0) PG8_BAR; }
        if constexpr (!Epi::AFTER_DRAIN) { E(acc, cur, wr, wc, fr, fq); S.done(cur); }
        if (!has_next) break;
#pragma unroll
        for (int a = 0; a < 2; ++a)
#pragma unroll
            for (int b = 0; b < 2; ++b)
#pragma unroll
                for (int m = 0; m < 4; ++m)
#pragma unroll
                    for (int n = 0; n < 2; ++n) acc[a][b][m][n] = (f32x4){0.f, 0.f, 0.f, 0.f};
        cur = nxt; cA = nA; cB = nB; ++ui;
        if constexpr (ALIGN_EPI) { if (wr == 1) PG8_BAR; }
    }
    PG8_WAIT_V(0);
    if constexpr (!ALIGN_EPI) { if (wr == 0) PG8_BAR; }
    PG8_BAR;
    if constexpr (Epi::AFTER_DRAIN) { E.fused(acc, cur, wr, wc, fr, fq, lds, wid, lane); S.done(cur); }
#undef PG8_SA
#undef PG8_SB
#undef PG8_STAGE
#undef PG8_LDA
#undef PG8_LDB
#undef PG8_MMA
#undef PG8_WAIT_V
#undef PG8_WAIT_L
#undef PG8_BAR
#undef PG8_SCHED
}
}
using pg8::Unit;
#define LDS_WAIT() asm volatile("s_waitcnt lgkmcnt(0)" ::: "memory")
typedef const f32x4 (&AccRef)[2][2][4][2];
__device__ __forceinline__ void fmac_s(float& acc, float a, float b) { asm("v_fmac_f32 %0, %1, %2" : "+v"(acc) : "v"(a), "v"(b)); }
__device__ __forceinline__ int fresh_tid(int wv) { int t = wv * 64 + (int)__builtin_amdgcn_mbcnt_hi(~0u, __builtin_amdgcn_mbcnt_lo(~0u, 0u)); asm volatile("" : "+v"(t)); return t; }

struct Params { const float* in[22]; float* out; unsigned char* ws; int ph_lo, ph_hi; };
enum { I_X = 0, I_NG, I_FNG, I_RWIN, I_MUP, I_MUN, I_W0, I_WUP, I_A0, I_AUP, I_KK, I_KA, I_RK, I_LNW, I_LNB, I_RWOUT, I_GWIN, I_GLNG, I_GLNB, I_GWS, I_GBS, I_GWOUT };

struct EpiZ {
    static constexpr bool PERM = true, AFTER_DRAIN = false;
    bf16_t* Z; bf16_t* ZL; const float* rstd;
    __device__ __forceinline__ void operator()(AccRef acc, const Unit& u, int wr, int wc, int fr, int fq) const {
        const int row0 = u.pm * 256 + wr * 64 + fr, colb = u.pn * 256 + wc * 32 + 8 * fq;
#pragma unroll
        for (int ai = 0; ai < 2; ++ai)
#pragma unroll
            for (int m = 0; m < 4; ++m) { const int row = row0 + ai * 128 + m * 16;
#pragma unroll
                for (int bj = 0; bj < 2; ++bj) { const int col = colb + bj * 128;
                    const f32x4 v0 = acc[ai][bj][m][0], v1 = acc[ai][bj][m][1];
                    u32x4 w; w.x = pk2(v0[0], v0[1]); w.y = pk2(v0[2], v0[3]); w.z = pk2(v1[0], v1[1]); w.w = pk2(v1[2], v1[3]);
                    if (col < NRKV) *(u32x4*)(Z + (size_t)row * NRKV + col) = w;
                    else if (col < SHIFTC) *(u32x4*)(ZL + (size_t)row * NLORA + (col - NRKV)) = w; } }
    }
};
struct EpiGate {
    static constexpr bool PERM = true, AFTER_DRAIN = false;
    bf16_t* O; const float* rstd;
    __device__ __forceinline__ void operator()(AccRef acc, const Unit& u, int wr, int wc, int fr, int fq) const {
        const int row0 = u.pm * 256 + wr * 64 + fr, colb = u.pn * 256 + wc * 32 + 8 * fq;
#pragma unroll
        for (int ai = 0; ai < 2; ++ai)
#pragma unroll
            for (int m = 0; m < 4; ++m) { const int row = row0 + ai * 128 + m * 16;
#pragma unroll
                for (int bj = 0; bj < 2; ++bj) { bf16_t* op = O + (size_t)row * BR + colb + bj * 128;
                    const u32x4 ow = *(const u32x4*)op; float o[8]; unpack8(ow, o);
                    const f32x4 g0 = acc[ai][bj][m][0], g1 = acc[ai][bj][m][1];
#pragma unroll
                    for (int e = 0; e < 4; ++e) { o[e] *= siluf_(g0[e]); o[4 + e] *= siluf_(g1[e]); }
                    *(u32x4*)op = pack8(o); } }
    }
};
struct EpiH1 {
    static constexpr bool PERM = true, AFTER_DRAIN = false;
    const float* X; bf16_t* A; float* sumsq;
    __device__ __forceinline__ void operator()(AccRef acc, const Unit& u, int wr, int wc, int fr, int fq) const {
        const int row0 = u.pm * 256 + wr * 64 + fr, colb = u.pn * 256 + wc * 32 + 8 * fq;
#pragma unroll
        for (int ai = 0; ai < 2; ++ai)
#pragma unroll
            for (int m = 0; m < 4; ++m) { const int row = row0 + ai * 128 + m * 16; float ss = 0.f;
#pragma unroll
                for (int bj = 0; bj < 2; ++bj) { const size_t off = (size_t)row * DM + colb + bj * 128;
                    const f32x4 h0 = *(const f32x4*)(X + off) + acc[ai][bj][m][0], h1 = *(const f32x4*)(X + off + 4) + acc[ai][bj][m][1];
                    u32x4 w; w.x = pk2(h0[0], h0[1]); w.y = pk2(h0[2], h0[3]); w.z = pk2(h1[0], h1[1]); w.w = pk2(h1[2], h1[3]); *(u32x4*)(A + off) = w;
                    ss += (h0[0] * h0[0] + h0[1] * h0[1]) + (h0[2] * h0[2] + h0[3] * h0[3]) + (h1[0] * h1[0] + h1[1] * h1[1]) + (h1[2] * h1[2] + h1[3] * h1[3]); }
                ss += __shfl_xor(ss, 16); ss += __shfl_xor(ss, 32);
                if (fq == 0) atomicAdd(sumsq + row, ss); }
    }
};
struct EpiH2 {
    static constexpr bool PERM = true, AFTER_DRAIN = false;
    const bf16_t* X; bf16_t* H; float* sumsq;
    __device__ __forceinline__ void operator()(AccRef acc, const Unit& u, int wr, int wc, int fr, int fq) const {
        const int row0 = u.pm * 256 + wr * 64 + fr, colb = u.pn * 256 + wc * 32 + 8 * fq;
#pragma unroll
        for (int ai = 0; ai < 2; ++ai)
#pragma unroll
            for (int m = 0; m < 4; ++m) { const int row = row0 + ai * 128 + m * 16; float ss = 0.f;
#pragma unroll
                for (int bj = 0; bj < 2; ++bj) { const size_t off = (size_t)row * DM + colb + bj * 128;
                    float x[8]; unpack8(*(const u32x4*)(X + off), x);
                    const f32x4 a0 = acc[ai][bj][m][0], a1 = acc[ai][bj][m][1];
                    float hv[8];
#pragma unroll
                    for (int e = 0; e < 4; ++e) { hv[e] = x[e] + a0[e]; hv[4 + e] = x[4 + e] + a1[e]; }
                    *(u32x4*)(H + off) = pack8(hv);
#pragma unroll
                    for (int e = 0; e < 8; ++e) ss += hv[e] * hv[e]; }
                ss += __shfl_xor(ss, 16); ss += __shfl_xor(ss, 32);
                if (fq == 0) atomicAdd(sumsq + row, ss); }
    }
};
struct EpiL1 {
    static constexpr bool PERM = true, AFTER_DRAIN = false;
    bf16_t* UG; bf16_t* V; const float* sumsq1; float* lnsum; float* lnsq;
    __device__ __forceinline__ void operator()(AccRef acc, const Unit& u, int wr, int wc, int fr, int fq) const {
        const int row0 = u.pm * 256 + wr * 64 + fr;
#pragma unroll
        for (int ai = 0; ai < 2; ++ai)
#pragma unroll
            for (int m = 0; m < 4; ++m) { const int row = row0 + ai * 128 + m * 16; const float rs = __builtin_amdgcn_rsqf(sumsq1[row] * (1.f / DM) + 1e-5f);
                if (u.pn < 32) { const int ch = u.pn * 128 + wc * 32 + 8 * fq; float o[8];
#pragma unroll
                    for (int n = 0; n < 2; ++n)
#pragma unroll
                        for (int e = 0; e < 4; ++e) o[4 * n + e] = geluf_(acc[ai][0][m][n][e] * rs) * siluf_(acc[ai][1][m][n][e] * rs);
                    *(u32x4*)(UG + (size_t)row * BR + ch) = pack8(o);
                } else { float s = 0.f, s2 = 0.f;
#pragma unroll
                    for (int bj = 0; bj < 2; ++bj) { const int ch = (u.pn - 32) * 256 + bj * 128 + wc * 32 + 8 * fq; float o[8];
#pragma unroll
                        for (int n = 0; n < 2; ++n)
#pragma unroll
                            for (int e = 0; e < 4; ++e) { const float g = geluf_(acc[ai][bj][m][n][e] * rs); o[4 * n + e] = g; s += g; s2 += g * g; }
                        *(u32x4*)(V + (size_t)row * BR + ch) = pack8(o); }
                    s += __shfl_xor(s, 16); s += __shfl_xor(s, 32); s2 += __shfl_xor(s2, 16); s2 += __shfl_xor(s2, 32);
                    if (fq == 0) { atomicAdd(lnsum + row, s); atomicAdd(lnsq + row, s2); } } }
    }
};

__device__ __forceinline__ void transpose_load(float (&v)[32], const float* W, int ldw, const float* g, int k0, int scol0, int lane) {
    if (scol0 >= 0) { const float* src = W + (size_t)(k0 + (lane >> 5)) * ldw + scol0 + (lane & 31);
#pragma unroll
        for (int i = 0; i < 32; ++i) v[i] = src[(size_t)(2 * i) * ldw];
        if (g) { const float* gp = g + k0 + (lane >> 5);
#pragma unroll
            for (int i = 0; i < 32; ++i) v[i] *= gp[2 * i]; }
    } else {
#pragma unroll
        for (int i = 0; i < 32; ++i) v[i] = 0.f; }
}
__device__ __forceinline__ void transpose_store(const float (&v)[32], int K, bf16_t* WT, LAS float* scr, int k0, int drow0, int lane) {
#pragma unroll
    for (int i = 0; i < 32; ++i) scr[(2 * i + (lane >> 5)) * 33 + (lane & 31)] = v[i];
    LDS_WAIT();
    const int c = lane & 7;
#pragma unroll
    for (int j = 0; j < 4; ++j) { const int n = (lane >> 3) + 8 * j; const LAS float* s = scr + (8 * c) * 33 + n;
        u32x4 o; o.x = pk2(s[0 * 33], s[1 * 33]); o.y = pk2(s[2 * 33], s[3 * 33]); o.z = pk2(s[4 * 33], s[5 * 33]); o.w = pk2(s[6 * 33], s[7 * 33]);
        *(u32x4*)(WT + (size_t)(drow0 + n) * K + k0 + 8 * c) = o; }
    LDS_WAIT();
}
template <class CM> __device__ __forceinline__ void convert_matrix(const float* W, int ldw, int K, int nrows, bf16_t* WT, const float* g, LAS float* scr, int gw, int NGW, int lane, CM colmap) {
    const int nblk = nrows / 32, nitems = (K / 64) * nblk;
    int it = gw;
    if (it >= nitems) return;
    float va[32], vb[32];
    transpose_load(va, W, ldw, g, 64 * (it / nblk), colmap(32 * (it % nblk)), lane);
    for (;;) {
        const int it1 = it + NGW;
        if (it1 < nitems) transpose_load(vb, W, ldw, g, 64 * (it1 / nblk), colmap(32 * (it1 % nblk)), lane);
        transpose_store(va, K, WT, scr, 64 * (it / nblk), 32 * (it % nblk), lane);
        if (it1 >= nitems) break;
        const int it2 = it1 + NGW;
        if (it2 < nitems) transpose_load(va, W, ldw, g, 64 * (it2 / nblk), colmap(32 * (it2 % nblk)), lane);
        transpose_store(vb, K, WT, scr, 64 * (it1 / nblk), 32 * (it1 % nblk), lane);
        if (it2 >= nitems) break;
        it = it2;
    }
}

constexpr int SCN = 37440;
constexpr int SI_X = 0, SI_H = 2304, SI_T = 4608, SI_V = 6656, SI_G7 = 8704, SI_SZ = 8960;
constexpr int SO_GT = 17920, SO_P = 18944, SO_UV = 20992, SO_Y = 23040, SO_L0 = 27136, SO_L1 = 29184, SO_C = 33280, SO_B = 37376;
static_assert(4 * SCN <= LDS_BYTES, "scan LDS");
constexpr int XS = 72;

#define WG_BAR() do { asm volatile("s_waitcnt lgkmcnt(0)" ::: "memory"); __builtin_amdgcn_s_barrier(); asm volatile("" ::: "memory"); } while (0)
__device__ __forceinline__ void scan_phase(LAS unsigned char* lds, const Params& p, const int pg, const int wv) {
    const int tid = fresh_tid(wv), lane = tid & 63, wave = __builtin_amdgcn_readfirstlane(tid >> 6);
    const int sc = wave & 3, role = wave >> 2, pair = sc >> 1, dir = sc & 1;
    const int bh = 2 * pg + pair, b = bh >> 6, h = bh & 63;
    LAS unsigned char* base = lds + sc * SCN;
    LAS float* GT = (LAS float*)(base + SO_GT);
    LAS float* Ps = (LAS float*)(base + SO_P);
    LAS bf16_t* UV = (LAS bf16_t*)(base + SO_UV);
    LAS float* yb = (LAS float*)(base + SO_Y);
    LAS float* lsc0 = (LAS float*)(base + SO_L0);
    LAS float* lsc1 = (LAS float*)(base + SO_L1);
    LAS float* cst = (LAS float*)(base + SO_C);
    LAS float* bon = (LAS float*)(base + SO_B);
    const int sn = lane & 7, kq = lane >> 4;
    const bf16_t* ZLb = (const bf16_t*)(p.ws + WS_ZLP) + (size_t)b * TSEQ * NLORA + dir * 96 + kq * 8;
    const bf16x8* lwu = (const bf16x8*)(p.ws + WS_LORA) + (size_t)(((((role == 0 ? 1 : 0) * 2 + dir) * 64 + h) * 12)) * 64;
    const unsigned ulane = (unsigned)lane;
#define WF_LOAD(w) do { unsigned _ul = ulane; asm volatile("" : "+v"(_ul));     \
        _Pragma("unroll") for (int ks = 0; ks < 3; ++ks) _Pragma("unroll") for (int nt = 0; nt < 4; ++nt) w[ks][nt] = lwu[(unsigned)((ks * 4 + nt) * 64) + _ul]; } while (0)
#define LORA_LOAD(sfv, cn, mat) do { const int _ts = dir ? (2047 - 8 * (cn) - sn) : (8 * (cn) + sn); \
        _Pragma("unroll") for (int ks = 0; ks < 3; ++ks) sfv[ks] = *(const bf16x8*)(ZLb + (size_t)_ts * NLORA + (mat) * 192 + ks * 32); } while (0)
#define LORA_MMA(wfv, sfv, dstp) do { _Pragma("unroll") for (int nt = 0; nt < 4; ++nt) { f32x4 _acc = (f32x4){0.f, 0.f, 0.f, 0.f}; \
        _Pragma("unroll") for (int ks = 0; ks < 3; ++ks) _acc = __builtin_amdgcn_mfma_f32_16x16x32_bf16(wfv[ks][nt], sfv[ks], _acc, 0, 0, 0); \
        if ((lane & 15) < 8) *(LAS f32x4*)((dstp) + (lane & 15) * 64 + 16 * nt + 4 * kq) = _acc; } } while (0)
    volatile LAS unsigned* pgall = (volatile LAS unsigned*)(lds + 149760 + 128);
    if (tid < 8) pgall[tid] = 0u;
    __syncthreads();
    volatile LAS unsigned* pgm = pgall + 2 * sc;
    volatile LAS unsigned* pgo = pgall + 2 * (sc ^ 1);
#define PAIR_SYNC(c) do { asm volatile("s_waitcnt lgkmcnt(0)" ::: "memory"); pgm[role] = (unsigned)(c) + 1u; \
        while (pgm[role ^ 1] < (unsigned)(c) + 1u) __builtin_amdgcn_s_sleep(3);        asm volatile("" ::: "memory"); } while (0)
    if (role == 0) {
        const int n = lane & 15, q = lane >> 4;
        f32x4 Sacc[4][4];
#pragma unroll
        for (int mt = 0; mt < 4; ++mt)
#pragma unroll
            for (int nt = 0; nt < 4; ++nt) Sacc[mt][nt] = (f32x4){0.f, 0.f, 0.f, 0.f};
        bf16x8 w1[3][4], sf1[3];
        WF_LOAD(w1); LORA_LOAD(sf1, 0, 1); LORA_MMA(w1, sf1, lsc1);
        WF_LOAD(w1); LORA_LOAD(sf1, 1, 1);
        for (int c = 0; c < 258; ++c) {
            PAIR_SYNC(c);
            if (c + 1 < 256) LORA_MMA(w1, sf1, lsc1 + ((c + 1) & 1) * 512);
            __builtin_amdgcn_sched_barrier(0);
            if (c >= 1 && c <= 256) {
                const int cc = c - 1;
                const LAS unsigned char* in = base + (cc & 1) * SI_SZ;
                const LAS bf16_t* Xs = (const LAS bf16_t*)(in + SI_X); const LAS bf16_t* Hs = (const LAS bf16_t*)(in + SI_H); const LAS bf16_t* Tk = (const LAS bf16_t*)(in + SI_T);
                const LAS float* vb = (const LAS float*)(in + SI_V); const LAS float* g7 = (const LAS float*)(in + SI_G7);
                LAS float* yq = yb + (cc & 1) * 512;
                { f32x4 G = (f32x4){0.f, 0.f, 0.f, 0.f};
#pragma unroll
                  for (int ks = 0; ks < 2; ++ks) { const bf16x8 hf = *(const LAS bf16x8*)(Hs + n * XS + 32 * ks + 8 * q), xf = *(const LAS bf16x8*)(Xs + n * XS + 32 * ks + 8 * q);
                      G = __builtin_amdgcn_mfma_f32_16x16x32_bf16(hf, xf, G, 0, 0, 0); }
                  *(LAS f32x4*)(GT + n * 16 + 4 * q) = G; }
                __builtin_amdgcn_sched_barrier(0);
                { bf16x8 xp[2];
#pragma unroll
                  for (int ks = 0; ks < 2; ++ks) { const u32x2 lo = *(const LAS u32x2*)(Xs + n * XS + 32 * ks + 4 * q), hi = *(const LAS u32x2*)(Xs + n * XS + 32 * ks + 16 + 4 * q);
                      const u32x4 w = (u32x4){lo.x, lo.y, hi.x, hi.y}; xp[ks] = __builtin_bit_cast(bf16x8, w); }
#pragma unroll
                  for (int nt = 0; nt < 4; ++nt) { f32x4 acc = (f32x4){0.f, 0.f, 0.f, 0.f}; __builtin_amdgcn_sched_barrier(0);
#pragma unroll
                      for (int ks = 0; ks < 2; ++ks) { const f32x4 s0 = Sacc[2 * ks][nt], s1 = Sacc[2 * ks + 1][nt];
                          const u32x4 w = (u32x4){pk2(s0[0], s0[1]), pk2(s0[2], s0[3]), pk2(s1[0], s1[1]), pk2(s1[2], s1[3])};
                          acc = __builtin_amdgcn_mfma_f32_16x16x32_bf16(xp[ks], __builtin_bit_cast(bf16x8, w), acc, 0, 0, 0); }
                      LAS float* dst = (q < 2) ? (Ps + (16 * nt + n) * 8 + 4 * q) : (yq + (16 * nt + n) * 8 + 4 * (q - 2));
                      *(LAS f32x4*)dst = acc; } }
                LDS_WAIT();
                __builtin_amdgcn_sched_barrier(0);
                float sa[8], y[8], vj[8];
                { const f32x4 p0 = *(const LAS f32x4*)(Ps + lane * 8), p1 = *(const LAS f32x4*)(Ps + lane * 8 + 4), q0 = *(const LAS f32x4*)(yq + lane * 8), q1 = *(const LAS f32x4*)(yq + lane * 8 + 4);
#pragma unroll
                  for (int e = 0; e < 4; ++e) { sa[e] = p0[e]; sa[4 + e] = p1[e]; y[e] = q0[e]; y[4 + e] = q1[e]; }
#pragma unroll
                  for (int j = 0; j < 8; ++j) vj[j] = vb[j * 64 + lane]; }
#pragma unroll
                for (int s = 1; s < 8; ++s) { float g[16];
                    __builtin_amdgcn_sched_barrier(0);
#pragma unroll
                    for (int t = 0; t < 4; ++t) if ((t & 1) * 4 < s) { const f32x4 gv = *(const LAS f32x4*)(GT + s * 16 + 4 * t); g[4 * t] = gv[0]; g[4 * t + 1] = gv[1]; g[4 * t + 2] = gv[2]; g[4 * t + 3] = gv[3]; }
                    float acc = sa[s];
#pragma unroll
                    for (int j = 0; j < s; ++j) { fmac_s(acc, sa[j], g[j]); fmac_s(acc, vj[j], g[8 + j]); }
                    sa[s] = acc; }
#pragma unroll
                for (int s = 0; s < 8; ++s) { float g[16];
                    __builtin_amdgcn_sched_barrier(0);
#pragma unroll
                    for (int t = 0; t < 4; ++t) if ((t & 1) * 4 <= s) { const f32x4 gv = *(const LAS f32x4*)(GT + (8 + s) * 16 + 4 * t); g[4 * t] = gv[0]; g[4 * t + 1] = gv[1]; g[4 * t + 2] = gv[2]; g[4 * t + 3] = gv[3]; }
                    float acc = y[s];
#pragma unroll
                    for (int j = 0; j <= s; ++j) { fmac_s(acc, sa[j], g[j]); fmac_s(acc, vj[j], g[8 + j]); }
                    y[s] = acc; }
                *(LAS f32x4*)(yq + lane * 8) = (f32x4){y[0], y[1], y[2], y[3]}; *(LAS f32x4*)(yq + lane * 8 + 4) = (f32x4){y[4], y[5], y[6], y[7]};
                *(LAS u32x4*)(UV + lane * 16) = pack8(sa); *(LAS u32x4*)(UV + lane * 16 + 8) = pack8(vj);
                LDS_WAIT();
                __builtin_amdgcn_sched_barrier(0);
                { bf16x8 tk[4], uv[4]; f32x4 gv[4];
                  const u32x4 z4 = (u32x4){0u, 0u, 0u, 0u};
#pragma unroll
                  for (int t = 0; t < 4; ++t) { gv[t] = *(const LAS f32x4*)(g7 + 16 * t + 4 * q);
                      const u32x4 a = *(const LAS u32x4*)(Tk + (16 * t + n) * 16 + 8 * (q & 1)), bq = *(const LAS u32x4*)(UV + (16 * t + n) * 16 + 8 * (q & 1));
                      tk[t] = __builtin_bit_cast(bf16x8, a); uv[t] = __builtin_bit_cast(bf16x8, q < 2 ? bq : z4); }
#pragma unroll
                  for (int mt = 0; mt < 4; ++mt)
#pragma unroll
                      for (int nt = 0; nt < 4; ++nt) { __builtin_amdgcn_sched_barrier(0); Sacc[mt][nt] = __builtin_amdgcn_mfma_f32_16x16x32_bf16(tk[mt], uv[nt], Sacc[mt][nt] * gv[mt], 0, 0, 0); } }
                __builtin_amdgcn_sched_barrier(0);
            }
            __builtin_amdgcn_sched_barrier(0);
            { const int cn2 = c + 2 < 256 ? c + 2 : 255; LORA_LOAD(sf1, cn2, 1); }
        }
    } else {
        { const float* mup = p.in[I_MUP]; const float* mun = p.in[I_MUN]; const int hc = h * 64 + lane;
#pragma unroll
          for (int X = 0; X < 3; ++X) { const float a_ = mup[X * BR + hc], b_ = mun[X * BR + hc]; cst[X * 64 + lane] = 1.f - a_ - b_; cst[(3 + X) * 64 + lane] = a_; cst[(6 + X) * 64 + lane] = b_; }
          cst[9 * 64 + lane] = p.in[I_KK][hc]; cst[10 * 64 + lane] = p.in[I_KA][hc]; cst[11 * 64 + lane] = p.in[I_RK][hc];
          cst[12 * 64 + lane] = p.in[I_LNW][hc]; cst[13 * 64 + lane] = p.in[I_LNB][hc];
          cst[14 * 64 + lane] = p.in[I_W0][dir * BR + hc]; cst[15 * 64 + lane] = p.in[I_A0][dir * BR + hc]; }
        LDS_WAIT();
        const int i = lane >> 3, j = lane & 7;
        bf16x8 wf[3][4]; WF_LOAD(wf);
        const char* Zc = (const char*)((const bf16_t*)(p.ws + WS_Z) + (size_t)b * TSEQ * NRKV + h * 64);
        bf16_t* EX = (bf16_t*)p.out + (size_t)b * TSEQ * BR + h * 64 + 8 * j;
        float* BS = (float*)(p.ws + WS_BSC) + (size_t)b * TSEQ * 64 + h;
        const int src2 = 8 * ((i & ~3) + 1) + j, src3 = 24 + j;
        u32x4 x0[3], xm[3], xp[3]; u32x4 exn = (u32x4){0u, 0u, 0u, 0u}; float bon_n = 0.f;
#define ISSUE_Z(cn) do { const int _t = dir ? (2047 - 8 * (cn) - i) : (8 * (cn) + i); const unsigned _o = ((unsigned)_t * NRKV + 8u * (unsigned)j) * 2u; \
            const unsigned _om = _t > 0 ? _o - 2u * NRKV : _o, _op = _t < TSEQ - 1 ? _o + 2u * NRKV : _o; \
            _Pragma("unroll") for (int X = 0; X < 3; ++X) { const char* _zx = Zc + (size_t)X * (BR * 2); x0[X] = *(const u32x4*)(_zx + _o); xm[X] = *(const u32x4*)(_zx + _om); xp[X] = *(const u32x4*)(_zx + _op); } } while (0)
#define ISSUE_EX(ccn) do { const int _t = dir ? (2047 - 8 * (ccn) - i) : (8 * (ccn) + i); exn = *(const u32x4*)(EX + (size_t)_t * BR); bon_n = BS[(size_t)_t * 64]; } while (0)
#define LDC(dst, k) do { const f32x4 _a = *(const LAS f32x4*)(cst + (k) * 64 + 8 * j), _b = *(const LAS f32x4*)(cst + (k) * 64 + 8 * j + 4); dst[0] = (f32x2){_a[0], _a[1]}; dst[1] = (f32x2){_a[2], _a[3]}; dst[2] = (f32x2){_b[0], _b[1]}; dst[3] = (f32x2){_b[2], _b[3]}; } while (0)
#define LD8(dst, ptr) do { const f32x4 _a = *(const LAS f32x4*)(ptr), _b = *(const LAS f32x4*)((ptr) + 4); dst[0] = (f32x2){_a[0], _a[1]}; dst[1] = (f32x2){_a[2], _a[3]}; dst[2] = (f32x2){_b[0], _b[1]}; dst[3] = (f32x2){_b[2], _b[3]}; } while (0)
#define PK8(v) ((u32x4){pk2(v[0].x, v[0].y), pk2(v[1].x, v[1].y), pk2(v[2].x, v[2].y), pk2(v[3].x, v[3].y)})
        bf16x8 sf0[3];
        ISSUE_Z(0); LORA_LOAD(sf0, 0, 0);
        for (int c = 0; c < 258; ++c) {
            PAIR_SYNC(c);
            if (c == 130) { while (pgo[1] < 131u) __builtin_amdgcn_s_sleep(1); asm volatile("" ::: "memory"); ISSUE_EX(128); }
            f32x2 rr[4], kp[4], vp[4];
            if (c < 256) {
                const int t = dir ? (2047 - 8 * c - i) : (8 * c + i);
                const bool hm = t > 0, hp = t < TSEQ - 1;
#pragma unroll
                for (int X = 0; X < 3; ++X) { f32x2 c0[4], cp[4], cn[4]; __builtin_amdgcn_sched_barrier(0); LDC(c0, X); LDC(cp, 3 + X); LDC(cn, 6 + X);
                    u32x4 wm = xm[X], wp = xp[X]; const u32x4 w0 = x0[X];
                    if (c == 0 || c == 255) { wm = hm ? wm : (u32x4){0u, 0u, 0u, 0u}; wp = hp ? wp : (u32x4){0u, 0u, 0u, 0u}; }
#pragma unroll
                    for (int qq = 0; qq < 4; ++qq) { const f32x2 z0 = (f32x2){bflo(w0[qq]), bfhi(w0[qq])}, zm = (f32x2){bflo(wm[qq]), bfhi(wm[qq])}, zp = (f32x2){bflo(wp[qq]), bfhi(wp[qq])};
                        const f32x2 z = zp * cn[qq] + (zm * cp[qq] + z0 * c0[qq]);
                        if (X == 0) rr[qq] = z; else if (X == 1) kp[qq] = z; else vp[qq] = z; } }
            }
            __builtin_amdgcn_sched_barrier(0);
            if (c >= 2) {
                const int cc = c - 2; const int t = dir ? (2047 - 8 * cc - i) : (8 * cc + i);
                const bool second = cc >= 128;
                const LAS float* yo = yb + (cc & 1) * 512 + (8 * j) * 8 + i;
                float y[8];
#pragma unroll
                for (int e = 0; e < 8; ++e) y[e] = yo[e * 8];
                const float bmine = bon[(cc & 1) * 8 + i];
                if (!second) { *(u32x4*)(EX + (size_t)t * BR) = pack8(y); if (j == 0) BS[(size_t)t * 64] = bmine; }
                else {
                    float e8[8]; unpack8(exn, e8); float s = 0.f;
#pragma unroll
                    for (int e = 0; e < 8; ++e) { y[e] += e8[e]; s += y[e]; }
                    const float mean = oct_sum(s) * (1.f / 64.f); float qq = 0.f;
#pragma unroll
                    for (int e = 0; e < 8; ++e) { y[e] -= mean; qq += y[e] * y[e]; }
                    const float rstd = __builtin_amdgcn_rsqf(oct_sum(qq) * (1.f / 64.f) + 64e-5f);
                    const LAS float* vin = (const LAS float*)(base + (cc & 1) * SI_SZ + SI_V) + i * 64 + 8 * j;
                    const f32x4 va = *(const LAS f32x4*)vin, vb2 = *(const LAS f32x4*)(vin + 4);
                    const f32x4 lwa = *(const LAS f32x4*)(cst + 12 * 64 + 8 * j), lwb = *(const LAS f32x4*)(cst + 12 * 64 + 8 * j + 4);
                    const f32x4 lba = *(const LAS f32x4*)(cst + 13 * 64 + 8 * j), lbb = *(const LAS f32x4*)(cst + 13 * 64 + 8 * j + 4);
                    const float bsum = bmine + bon_n; float o[8];
#pragma unroll
                    for (int e = 0; e < 4; ++e) { o[e] = y[e] * rstd * lwa[e] + lba[e] + bsum * va[e]; o[4 + e] = y[4 + e] * rstd * lwb[e] + lbb[e] + bsum * vb2[e]; }
                    *(u32x4*)(EX + (size_t)t * BR) = pack8(o);
                }
            }
            __builtin_amdgcn_sched_barrier(0);
            if (c < 256) {
                LORA_MMA(wf, sf0, lsc0);
                LDS_WAIT();
                LAS unsigned char* ob = base + (c & 1) * SI_SZ;
                LAS bf16_t* Xs = (LAS bf16_t*)(ob + SI_X); LAS bf16_t* Hs = (LAS bf16_t*)(ob + SI_H); LAS bf16_t* Tk = (LAS bf16_t*)(ob + SI_T);
                LAS float* vb = (LAS float*)(ob + SI_V); LAS float* g7 = (LAS float*)(ob + SI_G7);
                *(LAS f32x4*)(vb + i * 64 + 8 * j) = (f32x4){vp[0].x, vp[0].y, vp[1].x, vp[1].y}; *(LAS f32x4*)(vb + i * 64 + 8 * j + 4) = (f32x4){vp[2].x, vp[2].y, vp[3].x, vp[3].y};
                f32x2 cv[4], kk[4], ss2 = (f32x2){0.f, 0.f};
                LDC(cv, 9);
#pragma unroll
                for (int qq = 0; qq < 4; ++qq) { kk[qq] = kp[qq] * cv[qq]; ss2 = kk[qq] * kk[qq] + ss2; }
                const float inv = 1.f / fmaxf(sqrtf(oct_sum(ss2.x + ss2.y)), 1e-12f);
                __builtin_amdgcn_sched_barrier(0);
                f32x2 ad[4], kd[4];
                { f32x2 la2[4]; LD8(la2, lsc1 + (c & 1) * 512 + i * 64 + 8 * j); LDC(cv, 15);
#pragma unroll
                  for (int qq = 0; qq < 4; ++qq) { const f32x2 al = cv[qq] + la2[qq]; ad[qq] = (f32x2){sigmoidf_(al.x), sigmoidf_(al.y)}; kk[qq] = kk[qq] * inv; } }
                LDC(cv, 10);
#pragma unroll
                for (int qq = 0; qq < 4; ++qq) kd[qq] = kp[qq] * ((ad[qq] - 1.f) * cv[qq] + 1.f);
                LDC(cv, 11);
                { f32x2 bo2 = (f32x2){0.f, 0.f};
#pragma unroll
                  for (int qq = 0; qq < 4; ++qq) bo2 = (rr[qq] * kd[qq]) * cv[qq] + bo2;
                  const float bo = oct_sum(bo2.x + bo2.y);
                  if (j == 0) bon[(c & 1) * 8 + i] = bo; }
                __builtin_amdgcn_sched_barrier(0);
                f32x2 dec[4], inc[4];
                { f32x2 lw2[4]; LD8(lw2, lsc0 + i * 64 + 8 * j); LDC(cv, 14);
#pragma unroll
                  for (int qq = 0; qq < 4; ++qq) { const f32x2 wl = cv[qq] + lw2[qq];
                      dec[qq] = (f32x2){fexp(-0.6065306597126334f * sigmoidf_(wl.x)), fexp(-0.6065306597126334f * sigmoidf_(wl.y))}; } }
#pragma unroll
                for (int qq = 0; qq < 4; ++qq) { float xs[2] = {dec[qq].x, dec[qq].y};
#pragma unroll
                    for (int hh = 0; hh < 2; ++hh) { float x = xs[hh];
                        x *= __builtin_bit_cast(float, __builtin_amdgcn_update_dpp(0x3f800000, __builtin_bit_cast(int, x), 0x118, 0xf, 0xf, false));
                        const float t2 = __shfl(x, src2); x = (i & 2) ? x * t2 : x;
                        const float t3 = __shfl(x, src3); x = (i & 4) ? x * t3 : x;
                        xs[hh] = x; }
                    inc[qq] = (f32x2){xs[0], xs[1]}; }
                if (i == 7) { *(LAS f32x4*)(g7 + 8 * j) = (f32x4){inc[0].x, inc[0].y, inc[1].x, inc[1].y}; *(LAS f32x4*)(g7 + 8 * j + 4) = (f32x4){inc[2].x, inc[2].y, inc[3].x, inc[3].y}; }
                f32x2 bhv[4], khv[4];
                { f32x2 at[4], rt[4];
#pragma unroll
                  for (int qq = 0; qq < 4; ++qq) { const f32x2 ig = (f32x2){frcp(inc[qq].x), frcp(inc[qq].y)}, ex = inc[qq] * (f32x2){frcp(dec[qq].x), frcp(dec[qq].y)};
                      at[qq] = -(kk[qq] * ex); rt[qq] = rr[qq] * inc[qq]; bhv[qq] = (kk[qq] * ad[qq]) * ig; khv[qq] = kd[qq] * ig; }
                  *(LAS u32x4*)(Xs + i * XS + 8 * j) = PK8(at); *(LAS u32x4*)(Xs + (8 + i) * XS + 8 * j) = PK8(rt);
                  *(LAS u32x4*)(Hs + i * XS + 8 * j) = PK8(bhv); *(LAS u32x4*)(Hs + (8 + i) * XS + 8 * j) = PK8(khv); }
                LDS_WAIT();
                { f32x2 gg[4]; LD8(gg, g7 + 8 * j);
#pragma unroll
                  for (int qq = 0; qq < 4; ++qq) { const f32x2 bc = bhv[qq] * gg[qq], kc = khv[qq] * gg[qq];
                      const unsigned wb = pk2(bc.x, bc.y), wk = pk2(kc.x, kc.y);
                      Tk[(8 * j + 2 * qq) * 16 + i] = (bf16_t)wb; Tk[(8 * j + 2 * qq + 1) * 16 + i] = (bf16_t)(wb >> 16);
                      Tk[(8 * j + 2 * qq) * 16 + 8 + i] = (bf16_t)wk; Tk[(8 * j + 2 * qq + 1) * 16 + 8 + i] = (bf16_t)(wk >> 16); } }
            }
            asm volatile("s_waitcnt vmcnt(0)" ::: "memory");
            __builtin_amdgcn_sched_barrier(0);
            { const int cn1 = c + 1 < 256 ? c + 1 : 255; ISSUE_Z(cn1); LORA_LOAD(sf0, cn1, 0); }
            if (c >= 130) { const int ccn = c - 1 < 255 ? c - 1 : 255; while (pgo[1] < (unsigned)(259 - ccn)) __builtin_amdgcn_s_sleep(1); asm volatile("" ::: "memory"); ISSUE_EX(ccn); }
        }
#undef ISSUE_Z
#undef ISSUE_EX
#undef LDC
#undef LD8
#undef PK8
    }
#undef PAIR_SYNC
#undef LORA_LOAD
#undef LORA_MMA
#undef WF_LOAD
    __syncthreads();
}

__device__ __forceinline__ void sgu_phase(LAS unsigned char* lds, const Params& p, const int wv) {
    const int tid = fresh_tid(wv), lane = tid & 63, wave = __builtin_amdgcn_readfirstlane(tid >> 6), kq = lane >> 4, l15 = lane & 15;
    LAS bf16_t* vn = (LAS bf16_t*)lds;
    LAS bf16_t* wsl = (LAS bf16_t*)(lds + 69632);
    constexpr int VS = 264, WSS = 136;
    const bf16_t* V = (const bf16_t*)(p.ws + WS_V); bf16_t* UG = (bf16_t*)(p.ws + WS_UG); const bf16_t* wsb = (const bf16_t*)(p.ws + WS_WS);
    const float* lnsum = (const float*)(p.ws + WS_STATS) + MTOK; const float* lnsq = lnsum + MTOK;
    int cur_g = -1;
    for (int job = blockIdx.x; job < 2048; job += gridDim.x) {
        const int g = job & 15, tok0 = (job >> 4) * 128;
        if (g != cur_g) {
            cur_g = g;
#pragma unroll
            for (int k = 0; k < 4; ++k) { const int qi = tid + 512 * k, row = qi >> 4, c16 = qi & 15;
                *(LAS u32x4*)(wsl + row * WSS + c16 * 8) = *(const u32x4*)(wsb + (size_t)(g * 128 + row) * 128 + c16 * 8); }
        }
        {   const int cc = tid & 31, r0 = tid >> 5, ch = g * 256 + cc * 8;
            const f32x4 ga = *(const f32x4*)(p.in[I_GLNG] + ch), gb = *(const f32x4*)(p.in[I_GLNG] + ch + 4), ba = *(const f32x4*)(p.in[I_GLNB] + ch), bb = *(const f32x4*)(p.in[I_GLNB] + ch + 4);
#pragma unroll
            for (int q = 0; q < 8; ++q) { const int r = r0 + 16 * q, row = tok0 + r;
                const float mean = lnsum[row] * (1.f / BR), var = lnsq[row] * (1.f / BR) - mean * mean, rstd = __builtin_amdgcn_rsqf(fmaxf(var, 0.f) + 1e-5f);
                const u32x4 w = *(const u32x4*)(V + (size_t)row * BR + ch); float x[8]; unpack8(w, x);
#pragma unroll
                for (int e = 0; e < 4; ++e) { x[e] = (x[e] - mean) * rstd * ga[e] + ba[e]; x[4 + e] = (x[4 + e] - mean) * rstd * gb[e] + bb[e]; }
                *(LAS u32x4*)(vn + r * VS + cc * 8) = pack8(x); } }
        u32x2 ugv[8][2];
#pragma unroll
        for (int it = 0; it < 8; ++it)
#pragma unroll
            for (int dt = 0; dt < 2; ++dt) ugv[it][dt] = *(const u32x2*)(UG + (size_t)(tok0 + 16 * it + l15) * BR + g * 256 + 32 * wave + 16 * dt + 4 * kq);
        __syncthreads();
        f32x4 acc[2][8];
#pragma unroll
        for (int dt = 0; dt < 2; ++dt)
#pragma unroll
            for (int it = 0; it < 8; ++it) acc[dt][it] = (f32x4){0.f, 0.f, 0.f, 0.f};
#pragma unroll 1
        for (int ks = 0; ks < 4; ++ks) {
            bf16x8 xf[2];
#pragma unroll
            for (int dt = 0; dt < 2; ++dt)
#pragma unroll
                for (int e = 0; e < 8; ++e) xf[dt][e] = (short)vn[(32 * ks + 8 * kq + e) * VS + 32 * wave + 16 * dt + l15];
#pragma unroll
            for (int it = 0; it < 8; ++it) { const bf16x8 yf = *(const LAS bf16x8*)(wsl + (16 * it + l15) * WSS + 32 * ks + 8 * kq);
#pragma unroll
                for (int dt = 0; dt < 2; ++dt) acc[dt][it] = __builtin_amdgcn_mfma_f32_16x16x32_bf16(xf[dt], yf, acc[dt][it], 0, 0, 0); }
        }
#pragma unroll
        for (int it = 0; it < 8; ++it) { const int ti = 16 * it + l15; const float bs = p.in[I_GBS][g * 128 + ti];
#pragma unroll
            for (int dt = 0; dt < 2; ++dt) { bf16_t* up = UG + (size_t)(tok0 + ti) * BR + g * 256 + 32 * wave + 16 * dt + 4 * kq;
                const u32x2 uw = ugv[it][dt];
                u32x2 o; o.x = pk2(bflo(uw.x) * (acc[dt][it][0] + bs), bfhi(uw.x) * (acc[dt][it][1] + bs)); o.y = pk2(bflo(uw.y) * (acc[dt][it][2] + bs), bfhi(uw.y) * (acc[dt][it][3] + bs));
                *(u32x2*)up = o; } }
        __syncthreads();
    }
}

#define XB_TMO      128
#define XB_XCNT(j)  (256  + 64 * (j))
#define XB_XSUB(j)  (1280 + 64 * (j))
#define XB_XGEN(j)  (2304 + 64 * (j))
#define XB_TOP      3328
#define XB_TOPGEN   3392
#define XCD_BAR_WORDS 3456
#define XB_SPIN_CAP (1u << 18)

__device__ __forceinline__ unsigned xb_ld(unsigned* p)              { return __hip_atomic_load(p, __ATOMIC_RELAXED, __HIP_MEMORY_SCOPE_AGENT); }
__device__ __forceinline__ unsigned xb_add(unsigned* p, unsigned v) { return __hip_atomic_fetch_add(p, v, __ATOMIC_RELAXED, __HIP_MEMORY_SCOPE_AGENT); }
__device__ __forceinline__ unsigned xb_xcc_id() { return (unsigned)__builtin_amdgcn_s_getreg((3 << 11) | 20) & 0xFu; }
#define XB_SPIN(cond, bar) do { unsigned _sp = 0; while (cond) { __builtin_amdgcn_s_sleep(1); \
    if ((++_sp & 255u) == 0u) { if (xb_ld(&(bar)[XB_TMO])) break; if (_sp > XB_SPIN_CAP) { atomicAdd(&(bar)[XB_TMO], 1u); break; } } } } while (0)

struct XcdBarrier {
    unsigned* bar; unsigned x;
    volatile LAS unsigned* st;
};

__device__ __forceinline__ XcdBarrier xcd_barrier_post(unsigned* bar, volatile LAS unsigned* st, int wv) {
    XcdBarrier b; b.bar = bar; b.x = xb_xcc_id(); b.st = st;
    if (wv == 0 && __builtin_amdgcn_mbcnt_hi(~0u, __builtin_amdgcn_mbcnt_lo(~0u, 0u)) == 0u) (void)xb_add(&bar[XB_XCNT(b.x)], 1u);
    return b;
}
__device__ __forceinline__ void xcd_barrier_complete(unsigned* bar, unsigned x, unsigned& nloc, unsigned& nx) {
    const unsigned G = gridDim.x * gridDim.y * gridDim.z;
    unsigned sum, cnt, mine, sp = 0u;
    for (;;) {
        sum = 0u; cnt = 0u; mine = 0u;
#pragma unroll
        for (unsigned j = 0; j < 16; ++j) { const unsigned c = xb_ld(&bar[XB_XCNT(j)]); sum += c; cnt += (c > 0u) ? 1u : 0u; mine = (j == x) ? c : mine; }
        if (sum == G) break;
        __builtin_amdgcn_s_sleep(1);
        if ((++sp & 255u) == 0u) { if (xb_ld(&bar[XB_TMO])) break; if (sp > XB_SPIN_CAP) { atomicAdd(&bar[XB_TMO], 1u); break; } }
    }
    nloc = mine > 0u ? mine : 1u; nx = cnt > 0u ? cnt : 1u;
}

__device__ __forceinline__ void xcd_barrier(const XcdBarrier& b, int wv) {
    asm volatile("s_waitcnt vmcnt(0)" ::: "memory");
    __syncthreads();
    if (wv == 0 && __builtin_amdgcn_mbcnt_hi(~0u, __builtin_amdgcn_mbcnt_lo(~0u, 0u)) == 0u) {
        unsigned* bar = b.bar;
        __builtin_amdgcn_s_waitcnt(0);
        unsigned nloc = b.st[0], nx = b.st[1];
        if (nloc == 0u) { xcd_barrier_complete(bar, b.x, nloc, nx); b.st[0] = nloc; b.st[1] = nx; }
        const unsigned old = xb_add(&bar[XB_XSUB(b.x)], 1u);
        const unsigned gen = old / nloc;
        if (old + 1u == (gen + 1u) * nloc) {
            __builtin_amdgcn_fence(__ATOMIC_RELEASE, "agent");
            asm volatile("s_waitcnt vmcnt(0)" ::: "memory");
            const unsigned og = xb_add(&bar[XB_TOP], 1u);
            const unsigned tg = og / nx;
            if (og + 1u == (tg + 1u) * nx) xb_add(&bar[XB_TOPGEN], 1u);
            else XB_SPIN(xb_ld(&bar[XB_TOPGEN]) == tg, bar);
            __builtin_amdgcn_fence(__ATOMIC_ACQUIRE, "agent");
            xb_add(&bar[XB_XGEN(b.x)], 1u);
            asm volatile("s_waitcnt vmcnt(0)" ::: "memory");
        } else {
            XB_SPIN(xb_ld(&bar[XB_XGEN(b.x)]) == gen, bar);
            __builtin_amdgcn_fence(__ATOMIC_ACQUIRE, "agent");
            asm volatile("s_waitcnt vmcnt(0)" ::: "memory");
        }
    }
    __syncthreads();
}

__device__ __forceinline__ void grid_bar(unsigned* ctr, unsigned target, int wv) {
    __syncthreads();
    if (wv == 0) {
        __builtin_amdgcn_fence(__ATOMIC_RELEASE, "agent");
        if (__builtin_amdgcn_mbcnt_hi(~0u, __builtin_amdgcn_mbcnt_lo(~0u, 0u)) == 0u) {
            __hip_atomic_fetch_add(ctr, 1u, __ATOMIC_RELAXED, __HIP_MEMORY_SCOPE_AGENT);
            while (__hip_atomic_load(ctr, __ATOMIC_RELAXED, __HIP_MEMORY_SCOPE_AGENT) < target) __builtin_amdgcn_s_sleep(1);
        }
        __builtin_amdgcn_fence(__ATOMIC_ACQUIRE, "agent");
    }
    __syncthreads();
}
__global__ void __launch_bounds__(NTHREADS, 2) fwd_kernel(Params p) {
    __builtin_assume(__builtin_amdgcn_workitem_id_y() == 0); __builtin_assume(__builtin_amdgcn_workitem_id_z() == 0);
    extern __shared__ __attribute__((aligned(16))) unsigned char lds_raw[];
    LAS unsigned char* lds = (LAS unsigned char*)lds_raw;
    cg::grid_group grid = cg::this_grid();
    const int wv = __builtin_amdgcn_readfirstlane((int)threadIdx.x >> 6);
    const int G = gridDim.x, NGW = G * NWAVES;
    const size_t NGT = (size_t)G * NTHREADS;
    unsigned char* ws = p.ws;
    float* rstd0 = (float*)(ws + WS_RSTD0); float* stats = (float*)(ws + WS_STATS);
#define PHASE_IDS() const int tid = fresh_tid(wv), lane = tid & 63, wave = __builtin_amdgcn_readfirstlane(tid >> 6); const int gw = blockIdx.x * NWAVES + wave; \
    const size_t gtid = (size_t)blockIdx.x * NTHREADS + tid; LAS float* scr = (LAS float*)(lds + wave * 16384); (void)lane; (void)gw; (void)gtid; (void)scr
    const int lo = p.ph_lo, hi = p.ph_hi;
#define IN(k) (lo <= (k) && (k) < hi)
    unsigned* barctr = (unsigned*)(ws + WS_MISC + 400 * 1024);
    volatile LAS unsigned* xst = (volatile LAS unsigned*)(lds + 149760 + 64);
    if (wv == 0 && __builtin_amdgcn_mbcnt_hi(~0u, __builtin_amdgcn_mbcnt_lo(~0u, 0u)) == 0u) { xst[0] = 0u; xst[1] = 0u; }
    XcdBarrier xb; xb.bar = barctr; xb.x = 0u; xb.st = xst;
#define SEAM(k) do { if (IN(k) && IN((k) + 1)) { if ((k) == 0) { grid.sync(); xb = xcd_barrier_post(barctr, xst, wv); } else xcd_barrier(xb, wv); } } while (0)

    if (IN(0)) {
        PHASE_IDS();
        for (size_t k = gtid; k < 4 * MTOK; k += NGT) stats[k] = 0.f;
        for (size_t k = gtid; k < XCD_BAR_WORDS; k += NGT) barctr[k] = 0u;
        for (int m = gw; m < MTOK; m += NGW) {
            const f32x4* xr = (const f32x4*)(p.in[I_X] + (size_t)m * DM) + lane; f32x4 v[8]; float s = 0.f;
#pragma unroll
            for (int jj = 0; jj < 8; ++jj) { v[jj] = xr[64 * jj]; s += (v[jj][0] * v[jj][0] + v[jj][1] * v[jj][1]) + (v[jj][2] * v[jj][2] + v[jj][3] * v[jj][3]); }
            s = wave_sum(s);
            const float rs0 = 1.f / sqrtf(s * (1.f / DM) + 1e-5f);
            u32x2* o8 = (u32x2*)((bf16_t*)(ws + WS_A0) + (size_t)m * DM) + lane;
#pragma unroll
            for (int jj = 0; jj < 8; ++jj) { u32x2 o; o.x = pk2(v[jj][0] * rs0, v[jj][1] * rs0); o.y = pk2(v[jj][2] * rs0, v[jj][3] * rs0); o8[64 * jj] = o; }
        }
        convert_matrix(p.in[I_RWIN], RIN, DM, N1PAD, (bf16_t*)(ws + WS_WRKV), p.in[I_NG], scr, gw, NGW, lane, [](int n0) { return n0 < SHIFTC ? n0 : -1; });
        {
            u32x4* dst = (u32x4*)(ws + WS_LORA);
            for (size_t it = gtid; it < (size_t)2 * 2 * 64 * 3 * 4 * 64; it += NGT) {
                const int l = (int)(it & 63), nt = (int)((it >> 6) & 3), ks = (int)((it >> 8) % 3), hh = (int)((it / 768) & 63), d = (int)((it / 49152) & 1), mat = (int)(it / 98304);
                const float* up = (mat ? p.in[I_AUP] : p.in[I_WUP]) + (size_t)d * 96 * BR + (size_t)(32 * ks + 8 * (l >> 4)) * BR + 64 * hh + 16 * nt + (l & 15);
                float v[8];
#pragma unroll
                for (int e = 0; e < 8; ++e) v[e] = up[(size_t)e * BR];
                dst[it] = pack8(v); } }
        {   bf16_t* wsb = (bf16_t*)(ws + WS_WS);
            for (size_t k = gtid; k < (size_t)16 * 128 * 128 / 2; k += NGT) { const f32x2 v = *(const f32x2*)(p.in[I_GWS] + 2 * k); ((unsigned*)wsb)[k] = pk2(v.x, v.y); } }
    }
    SEAM(0);
    if (IN(1)) {
        pg8::Gemm g{(const bf16_t*)(ws + WS_A0), (const bf16_t*)(ws + WS_WRKV), MTOK, N1PAD, DM}; pg8::StaticOrder S; S.init(MTOK, N1PAD, G, (int)blockIdx.x);
        EpiZ E{(bf16_t*)(ws + WS_Z), (bf16_t*)(ws + WS_ZL), rstd0};
        pg8::gemm_phase<EpiZ, pg8::StaticOrder, true, true>(lds, g, S, E, wv);
    }
#if defined(REPEAT_PHASE) && REPEAT_PHASE == 1
    if (IN(1)) {
        pg8::Gemm g{(const bf16_t*)(ws + WS_A0), (const bf16_t*)(ws + WS_WRKV), MTOK, N1PAD, DM}; pg8::StaticOrder S; S.init(MTOK, N1PAD, G, (int)blockIdx.x);
        EpiZ E{(bf16_t*)(ws + WS_Z), (bf16_t*)(ws + WS_ZL), rstd0};
        pg8::gemm_phase<EpiZ, pg8::StaticOrder, true, true>(lds, g, S, E, wv);
    }
#endif
    SEAM(1);
    if (IN(2)) {
        PHASE_IDS();
        convert_matrix(p.in[I_RWIN], RIN, DM, BR, (bf16_t*)(ws + WS_WG), p.in[I_NG], scr, gw, NGW, lane, [](int n0) { return SHIFTC + n0; });
        convert_matrix(p.in[I_RWOUT], DM, BR, DM, (bf16_t*)(ws + WS_WO0), nullptr, scr, gw, NGW, lane, [](int n0) { return n0; });
        const bf16_t* ZL = (const bf16_t*)(ws + WS_ZL); bf16_t* ZLP = (bf16_t*)(ws + WS_ZLP);
        for (size_t it = gtid; it < (size_t)MTOK * 48; it += NGT) {
            const int row = (int)(it / 48), c0 = (int)(it % 48) * 8, t = row & (TSEQ - 1);
            const u32x4 z0 = *(const u32x4*)(ZL + (size_t)row * NLORA + c0);
            const u32x4 zm = t > 0 ? *(const u32x4*)(ZL + (size_t)(row - 1) * NLORA + c0) : (u32x4){0u, 0u, 0u, 0u};
            const u32x4 zp = t < TSEQ - 1 ? *(const u32x4*)(ZL + (size_t)(row + 1) * NLORA + c0) : (u32x4){0u, 0u, 0u, 0u};
            float a0[8], am[8], ap[8], o[8]; unpack8(z0, a0); unpack8(zm, am); unpack8(zp, ap);
#pragma unroll
            for (int e = 0; e < 8; ++e) { const float mp = p.in[I_MUP][NRKV + c0 + e], mn = p.in[I_MUN][NRKV + c0 + e];
                const float z = a0[e] + mp * (am[e] - a0[e]) + mn * (ap[e] - a0[e]); o[e] = c0 < 192 ? tanhf_(z) : z; }
            *(u32x4*)(ZLP + (size_t)row * NLORA + c0) = pack8(o);
        }
    }
    SEAM(2);
    if (IN(3)) { for (int pg = blockIdx.x; pg < 256; pg += G) scan_phase(lds, p, pg, wv); }
    SEAM(3);
    if (IN(4)) {
        PHASE_IDS();
        const float* g1 = p.in[I_NG] + DM;
        convert_matrix(p.in[I_GWIN], 3 * BR, DM, 3 * BR, (bf16_t*)(ws + WS_WIN1), g1, scr, gw, NGW, lane, [](int n0) {
            if (n0 >= 2 * BR) return BR + (n0 - 2 * BR);
            const int jj = n0 >> 8, half = (n0 >> 7) & 1, ii = n0 & 127; return (half ? 2 * BR : 0) + 128 * jj + ii; });
        convert_matrix(p.in[I_GWOUT], DM, BR, DM, (bf16_t*)(ws + WS_WO1), nullptr, scr, gw, NGW, lane, [](int n0) { return n0; });
        __syncthreads();
        pg8::Gemm g{(const bf16_t*)(ws + WS_A0), (const bf16_t*)(ws + WS_WG), MTOK, BR, DM}; pg8::StaticOrder S; S.init(MTOK, BR, G, (int)blockIdx.x);
        EpiGate E{(bf16_t*)p.out, rstd0};
        pg8::gemm_phase<EpiGate, pg8::StaticOrder, true, true>(lds, g, S, E, wv);
    }
    SEAM(4);
    if (IN(5)) {
        pg8::Gemm g{(const bf16_t*)p.out, (const bf16_t*)(ws + WS_WO0), MTOK, DM, BR}; pg8::StaticOrder S; S.init(MTOK, DM, G, (int)blockIdx.x);
        EpiH1 E{p.in[I_X], (bf16_t*)(ws + WS_A1), stats};
        pg8::gemm_phase<EpiH1, pg8::StaticOrder, true, true>(lds, g, S, E, wv);
    }
    SEAM(5);
    if (IN(6)) {
        pg8::Gemm g{(const bf16_t*)(ws + WS_A1), (const bf16_t*)(ws + WS_WIN1), MTOK, 3 * BR, DM}; pg8::StaticOrder S; S.init(MTOK, 3 * BR, G, (int)blockIdx.x);
        EpiL1 E{(bf16_t*)(ws + WS_UG), (bf16_t*)(ws + WS_V), stats, stats + MTOK, stats + 2 * MTOK};
        pg8::gemm_phase<EpiL1, pg8::StaticOrder, true, true>(lds, g, S, E, wv);
    }
    SEAM(6);
    if (IN(7)) sgu_phase(lds, p, wv);
    SEAM(7);
    if (IN(8)) {
        pg8::Gemm g{(const bf16_t*)(ws + WS_UG), (const bf16_t*)(ws + WS_WO1), MTOK, DM, BR}; pg8::StaticOrder S; S.init(MTOK, DM, G, (int)blockIdx.x);
        EpiH2 E{(const bf16_t*)(ws + WS_A1), (bf16_t*)(ws + WS_H1), stats + 3 * MTOK};
        pg8::gemm_phase<EpiH2, pg8::StaticOrder, true, true>(lds, g, S, E, wv);
    }
    SEAM(8);
    if (IN(9)) {
        PHASE_IDS();
        const float* ssq = stats + 3 * MTOK; const f32x4* gf = (const f32x4*)p.in[I_FNG] + lane;
        for (int m = gw; m < MTOK; m += 2 * NGW) {
            const int m2 = m + NGW < MTOK ? m + NGW : m;
            const float r = 1.f / sqrtf(ssq[m] * (1.f / DM) + 1e-5f), r2 = 1.f / sqrtf(ssq[m2] * (1.f / DM) + 1e-5f);
            const u32x2* hrow = (const u32x2*)((const bf16_t*)(ws + WS_H1) + (size_t)m * DM) + lane;
            const u32x2* hrow2 = (const u32x2*)((const bf16_t*)(ws + WS_H1) + (size_t)m2 * DM) + lane;
            u32x2 wa[8], wb[8];
#pragma unroll
            for (int jj = 0; jj < 8; ++jj) { wa[jj] = hrow[64 * jj]; wb[jj] = hrow2[64 * jj]; }
            f32x4* orow = (f32x4*)(p.out + (size_t)m * DM) + lane; f32x4* orow2 = (f32x4*)(p.out + (size_t)m2 * DM) + lane;
#pragma unroll
            for (int jj = 0; jj < 8; ++jj) { const f32x4 gv = gf[64 * jj];
                orow[64 * jj] = (f32x4){bflo(wa[jj].x), bfhi(wa[jj].x), bflo(wa[jj].y), bfhi(wa[jj].y)} * r * gv;
                if (m2 != m) orow2[64 * jj] = (f32x4){bflo(wb[jj].x), bfhi(wb[jj].x), bflo(wb[jj].y), bfhi(wb[jj].y)} * r2 * gv; }
        }
    }
}

extern "C" void kernel_launch(void* const* d_in, const int* in_sizes, int n_in, void* d_out, int out_size, void* d_ws, size_t ws_size, hipStream_t stream) {
    static int grid_blocks = 0;
    if (!grid_blocks) {
        int dev = 0, cus = 0, per_cu = 0;
        (void)hipGetDevice(&dev);
        (void)hipDeviceGetAttribute(&cus, hipDeviceAttributeMultiprocessorCount, dev);
        (void)hipFuncSetAttribute((const void*)fwd_kernel, hipFuncAttributeMaxDynamicSharedMemorySize, LDS_BYTES);
        (void)hipOccupancyMaxActiveBlocksPerMultiprocessor(&per_cu, (const void*)fwd_kernel, NTHREADS, LDS_BYTES);
        if (per_cu < 1) per_cu = 1;
        grid_blocks = cus * per_cu;
        if (ws_size < WS_END || n_in != 22) { fprintf(stderr, "kernel_launch: needs %zu bytes of workspace (got %zu), 22 inputs (got %d)\n", (size_t)WS_END, ws_size, n_in); grid_blocks = -1; }
    }
    if (grid_blocks < 0) return;
    Params p{};
    for (int i = 0; i < 22; ++i) p.in[i] = (const float*)d_in[i];
    p.out = (float*)d_out; p.ws = (unsigned char*)d_ws; p.ph_lo = 0; p.ph_hi = 10;
    void* args[] = {&p};
    hipError_t e = hipLaunchCooperativeKernel((void*)fwd_kernel, dim3(grid_blocks), dim3(NTHREADS), args, LDS_BYTES, stream);
    if (e != hipSuccess) fprintf(stderr, "cooperative launch failed: %s (grid %d)\n", hipGetErrorString(e), grid_blocks);
}
```
